# Optimizing an MI355X kernel written in HIP

```python
import jax, jax.numpy as jnp
from jax import lax
import numpy as np

D_MODEL = 2048
BATCH = 8
SEQ = 2048
DEPTH = 2

N_EVEN = (DEPTH + 1) // 2
N_ODD = DEPTH // 2

RET_HEADS = 4
RET_DK = 256
RET_DV = 256
RET_THETA_BASE = 10000.0
GLA_HEADS = 4
GLA_DK = 128
GLA_DV = 256
GLA_GATE_RANK = 16
GLA_GATE_NORM = 16.0
CHUNK = 64

RET_QK = RET_HEADS * RET_DK
RET_V = RET_HEADS * RET_DV
GLA_QK = GLA_HEADS * GLA_DK
GLA_V = GLA_HEADS * GLA_DV
MIX_WIDTH = RET_V + GLA_V
IN_SIZES = (RET_QK, RET_QK, RET_V, RET_V, GLA_QK, GLA_QK, GLA_V, GLA_V, GLA_GATE_RANK)
IN_WIDTH = sum(IN_SIZES)
IN_OFFSETS = tuple(int(o) for o in np.cumsum(IN_SIZES)[:-1])

ATT_HEADS = 16
ATT_HEAD_DIM = D_MODEL // ATT_HEADS
ATT_WIDTH = ATT_HEADS * ATT_HEAD_DIM
DILATED_BRANCHES = ((128, 1), (512, 4), (2048, 16))
ATT_BLOCK = 128

FFN_HIDDEN = -(-8 * D_MODEL // (3 * 256)) * 256
PLE_DIM = 256
NORM_EPS = 1e-6

kernel_name = 'hybrid_retention_gla_dilated_trunk'


def rms_norm(x, w):
    x32 = x.astype(jnp.float32)
    y = x32 * lax.rsqrt(jnp.mean(x32 * x32, axis=-1, keepdims=True) + NORM_EPS)
    return (y * w.astype(jnp.float32)).astype(x.dtype)


def xpos_rotate(t, positions):
    half = t.shape[-1] // 2
    inv_freq = 1.0 / jnp.power(RET_THETA_BASE, jnp.linspace(0.0, 1.0, half, dtype=jnp.float32))
    ang = positions.astype(jnp.float32)[..., None] * inv_freq
    cos, sin = jnp.cos(ang)[:, :, None, :], jnp.sin(ang)[:, :, None, :]
    t2 = t.reshape(*t.shape[:-1], half, 2)
    te, to = t2[..., 0], t2[..., 1]
    return jnp.stack([te * cos - to * sin, te * sin + to * cos], axis=-1).reshape(t.shape)


def to_chunks(t):
    b, s, h, d = t.shape
    return t.reshape(b, s // CHUNK, CHUNK, h, d).transpose(1, 0, 2, 3, 4)


def from_chunks(t):
    nc, b, c, h, d = t.shape
    return t.transpose(1, 0, 2, 3, 4).reshape(b, nc * c, h, d)


def retention(q, k, v):
    b, s, h, dk = q.shape
    dv = v.shape[-1]
    log_g = jnp.log1p(-jnp.exp2(-5.0 - jnp.arange(h, dtype=jnp.float32)))
    idx = jnp.arange(CHUNK, dtype=jnp.float32)
    rel = idx[:, None] - idx[None, :]
    intra_decay = jnp.where(rel[None] >= 0,
                            jnp.exp(jnp.maximum(rel, 0.0)[None] * log_g[:, None, None]), 0.0)
    q_decay = jnp.exp((idx + 1.0)[:, None] * log_g[None, :])
    k_decay = jnp.exp((CHUNK - 1.0 - idx)[:, None] * log_g[None, :])
    chunk_decay = jnp.exp(CHUNK * log_g)
    k = k * dk ** -0.5

    def step(state, inp):
        qc, kc, vc = inp
        sc = jnp.einsum('bihd,bjhd->bhij', qc, kc) * intra_decay
        o = (jnp.einsum('bhij,bjhe->bihe', sc, vc)
             + jnp.einsum('bihd,bhde->bihe', qc * q_decay[..., None], state))
        state = (state * chunk_decay[:, None, None]
                 + jnp.einsum('bjhd,bjhe->bhde', kc * k_decay[..., None], vc))
        return state, o

    init = jnp.zeros((b, h, dk, dv), jnp.float32)
    _, o = lax.scan(step, init, (to_chunks(q), to_chunks(k), to_chunks(v)))
    return from_chunks(o)


def gated_linear_attention(q, k, v, log_a):
    b, s, h, dk = q.shape
    dv = v.shape[-1]
    q = q * dk ** -0.5
    causal = jnp.tril(jnp.ones((CHUNK, CHUNK), dtype=bool))

    def step(state, inp):
        qc, kc, vc, ac = inp
        cum = jnp.cumsum(ac, axis=1)
        last = cum[:, -1]
        q_t = qc * jnp.exp(cum)
        k_t = kc * jnp.exp(-cum)
        sc = jnp.where(causal, jnp.einsum('bihd,bjhd->bhij', q_t, k_t), 0.0)
        o = (jnp.einsum('bhij,bjhe->bihe', sc, vc)
             + jnp.einsum('bihd,bhde->bihe', q_t, state))
        state = (jnp.exp(last)[..., None] * state
                 + jnp.einsum('bjhd,bjhe->bhde', kc * jnp.exp(last[:, None] - cum), vc))
        return state, o

    init = jnp.zeros((b, h, dk, dv), jnp.float32)
    _, o = lax.scan(step, init, (to_chunks(q), to_chunks(k), to_chunks(v), to_chunks(log_a)))
    return from_chunks(o)


def dilated_branch(q, k, v, window, dilation):
    b, s, h, d = q.shape
    span = window // dilation
    sub_len = s // dilation
    n_blk = -(-sub_len // ATT_BLOCK)
    pad_len = n_blk * ATT_BLOCK

    def strided(t):
        t = t.reshape(b, sub_len, dilation, h, d)
        return jnp.pad(t, ((0, 0), (0, pad_len - sub_len), (0, 0), (0, 0), (0, 0)))

    def band(t):
        t = jnp.pad(strided(t), ((0, 0), (ATT_BLOCK, 0), (0, 0), (0, 0), (0, 0)))
        prev = t[:, :pad_len].reshape(b, n_blk, ATT_BLOCK, dilation, h, d)
        cur = t[:, ATT_BLOCK:].reshape(b, n_blk, ATT_BLOCK, dilation, h, d)
        return jnp.concatenate([prev, cur], axis=2)

    qb = strided(q).reshape(b, n_blk, ATT_BLOCK, dilation, h, d)
    kb, vb = band(k), band(v)
    scores = jnp.einsum('bnqrhd,bnkrhd->bnrhqk', qb, kb) * d ** -0.5
    qi = jnp.arange(ATT_BLOCK)[:, None]
    kj = jnp.arange(2 * ATT_BLOCK)[None, :]
    dist = qi + ATT_BLOCK - kj
    key_pos = jnp.arange(n_blk)[:, None, None] * ATT_BLOCK + kj[None] - ATT_BLOCK
    valid = (dist >= 0)[None] & (dist <= span)[None] & (key_pos >= 0)
    scores = jnp.where(valid[None, :, None, None], scores, -jnp.inf)
    m = jnp.max(scores, axis=-1, keepdims=True)
    pr = jnp.exp(scores - m)
    den = jnp.sum(pr, axis=-1)
    out = jnp.einsum('bnrhqk,bnkrhd->bnqrhd', pr, vb) / jnp.transpose(den, (0, 1, 4, 2, 3))[..., None]
    lse = jnp.transpose(m[..., 0] + jnp.log(den), (0, 1, 4, 2, 3))
    out = out.reshape(b, pad_len, dilation, h, d)[:, :sub_len].reshape(b, s, h, d)
    lse = lse.reshape(b, pad_len, dilation, h)[:, :sub_len].reshape(b, s, h)
    return out, lse


def dilated_attention(q, k, v):
    outs, lses = [], []
    for window, dilation in DILATED_BRANCHES:
        o, l = dilated_branch(q, k, v, window, dilation)
        outs.append(o)
        lses.append(l)
    wts = jax.nn.softmax(jnp.stack(lses, axis=0), axis=0)
    return jnp.sum(wts[..., None] * jnp.stack(outs, axis=0), axis=0)


def retention_gla_mixer(xn, positions, w_in, gate_up, gate_b, ret_norm_w, gla_norm_w, w_out):
    b, s, _ = xn.shape
    z = (xn @ w_in).astype(jnp.float32)
    rq, rk, rv, rg, gq, gk, gv, gg, glr = jnp.split(z, IN_OFFSETS, axis=-1)
    rq = xpos_rotate(rq.reshape(b, s, RET_HEADS, RET_DK), positions)
    rk = xpos_rotate(rk.reshape(b, s, RET_HEADS, RET_DK), positions)
    ret = retention(rq, rk, rv.reshape(b, s, RET_HEADS, RET_DV))
    ret = rms_norm(ret, ret_norm_w.reshape(RET_HEADS, RET_DV)).astype(jnp.float32) \
        * jax.nn.silu(rg.reshape(b, s, RET_HEADS, RET_DV))
    log_a = jax.nn.log_sigmoid(glr @ gate_up.astype(jnp.float32) + gate_b.astype(jnp.float32)) / GLA_GATE_NORM
    gla = gated_linear_attention(gq.reshape(b, s, GLA_HEADS, GLA_DK), gk.reshape(b, s, GLA_HEADS, GLA_DK),
                                 gv.reshape(b, s, GLA_HEADS, GLA_DV), log_a.reshape(b, s, GLA_HEADS, GLA_DK))
    gla = rms_norm(gla, gla_norm_w.reshape(GLA_HEADS, GLA_DV)).astype(jnp.float32) \
        * jax.nn.silu(gg.reshape(b, s, GLA_HEADS, GLA_DV))
    o = jnp.concatenate([ret.reshape(b, s, RET_V), gla.reshape(b, s, GLA_V)], axis=-1)
    return o.astype(xn.dtype) @ w_out


def dilated_mixer(xn, w_qkv, w_out):
    b, s, _ = xn.shape
    q, k, v = jnp.split((xn @ w_qkv).astype(jnp.float32), 3, axis=-1)
    heads = lambda t: t.reshape(b, s, ATT_HEADS, ATT_HEAD_DIM)
    o = dilated_attention(heads(q), heads(k), heads(v))
    return o.reshape(b, s, ATT_WIDTH).astype(xn.dtype) @ w_out


def swiglu(xn, w_gate, w_up, w_down):
    return (jax.nn.silu(xn @ w_gate) * (xn @ w_up)) @ w_down


def setup_inputs(seed: int = 0) -> dict:
    key = jax.random.key(seed)
    ks = jax.random.split(key, 24)
    f32 = jnp.float32

    def w(k, shape, fan_in):
        return jax.random.normal(k, shape, f32) * fan_in ** -0.5

    def gain(k, shape):
        return 1.0 + 0.05 * jax.random.normal(k, shape, f32)

    x = jax.random.normal(ks[0], (BATCH, SEQ, D_MODEL), f32)
    p = jax.random.normal(ks[1], (DEPTH, BATCH, SEQ, PLE_DIM), f32)
    positions = (jnp.arange(SEQ, dtype=jnp.int32)[None, :]
                 + jax.random.randint(ks[2], (BATCH, 1), 0, 4096, dtype=jnp.int32))
    return {
        'x': x,
        'p': p,
        'positions': positions,
        'attn_norm_w': gain(ks[3], (DEPTH, D_MODEL)),
        'ffn_norm_w': gain(ks[4], (DEPTH, D_MODEL)),
        'ple_norm_w': gain(ks[5], (DEPTH, D_MODEL)),
        'final_norm_w': gain(ks[6], (D_MODEL,)),
        'ab_w_in': w(ks[7], (N_EVEN, D_MODEL, IN_WIDTH), D_MODEL),
        'ab_gla_gate_up': w(ks[8], (N_EVEN, GLA_GATE_RANK, GLA_QK), GLA_GATE_RANK),
        'ab_gla_gate_b': 0.1 * jax.random.normal(ks[9], (N_EVEN, GLA_QK), f32),
        'ab_ret_norm_w': gain(ks[10], (N_EVEN, RET_V)),
        'ab_gla_norm_w': gain(ks[11], (N_EVEN, GLA_V)),
        'ab_w_out': w(ks[12], (N_EVEN, MIX_WIDTH, D_MODEL), MIX_WIDTH),
        'c_w_qkv': w(ks[13], (N_ODD, D_MODEL, 3 * ATT_WIDTH), D_MODEL),
        'c_w_out': w(ks[14], (N_ODD, ATT_WIDTH, D_MODEL), ATT_WIDTH),
        'ffn_w_gate': w(ks[15], (DEPTH, D_MODEL, FFN_HIDDEN), D_MODEL),
        'ffn_w_up': w(ks[16], (DEPTH, D_MODEL, FFN_HIDDEN), D_MODEL),
        'ffn_w_down': w(ks[17], (DEPTH, FFN_HIDDEN, D_MODEL), FFN_HIDDEN),
        'ple_w_proj': w(ks[18], (DEPTH, PLE_DIM, D_MODEL), PLE_DIM),
        'ple_w_gate': w(ks[19], (DEPTH, D_MODEL, D_MODEL), D_MODEL),
    }


def reference(x, p, positions, attn_norm_w, ffn_norm_w, ple_norm_w, final_norm_w,
              ab_w_in, ab_gla_gate_up, ab_gla_gate_b, ab_ret_norm_w, ab_gla_norm_w, ab_w_out,
              c_w_qkv, c_w_out, ffn_w_gate, ffn_w_up, ffn_w_down, ple_w_proj, ple_w_gate):
    for i in range(DEPTH):
        j = i // 2
        xn = rms_norm(x, attn_norm_w[i])
        if i % 2 == 0:
            mix = retention_gla_mixer(xn, positions, ab_w_in[j], ab_gla_gate_up[j], ab_gla_gate_b[j],
                                      ab_ret_norm_w[j], ab_gla_norm_w[j], ab_w_out[j])
        else:
            mix = dilated_mixer(xn, c_w_qkv[j], c_w_out[j])
        h = x + mix
        h = h + swiglu(rms_norm(h, ffn_norm_w[i]), ffn_w_gate[i], ffn_w_up[i], ffn_w_down[i])
        gate = jax.nn.sigmoid(rms_norm(h, ple_norm_w[i]) @ ple_w_gate[i])
        x = h + gate * (p[i] @ ple_w_proj[i])
    return rms_norm(x, final_norm_w)
```

```cpp
#include <hip/hip_runtime.h>
#include <hip/hip_cooperative_groups.h>
#include <cstdio>
#include <cstdint>
#include <cmath>
namespace cg = cooperative_groups;

namespace pg8 {
#define PG8_LAS __attribute__((address_space(3)))
typedef unsigned short bf16_t;
typedef short bf16x8 __attribute__((ext_vector_type(8)));
typedef float f32x4 __attribute__((ext_vector_type(4)));
typedef unsigned u32x4 __attribute__((ext_vector_type(4)));
constexpr int BM = 256, BK = 64, HALF = 128, HTB = HALF * BK * 2  , STAGE_BYTES = 8 * HTB, NXCD = 8, WGM = 8;

__host__ __device__ __forceinline__ int lds_byte(int r, int c) { const int st = (r >> 4) * 2 + (c >> 5), rr = r & 15, cc = c & 31, ob = rr * 64 + cc * 2; return st * 1024 + (ob ^ (((ob >> 9) & 1) << 5)); }
__host__ __device__ __forceinline__ void stage_rc(int b, int& R, int& C) { const int st = b / 1024, sb = b % 1024, swz = sb ^ (((sb >> 9) & 1) << 5); R = (st >> 1) * 16 + swz / 64; C = (st & 1) * 32 + (swz % 64) / 2; }
__host__ __device__ __forceinline__ int perm32(int rho) { const int n = rho >> 4, i = rho & 15; return 8 * (i >> 2) + 4 * n + (i & 3); }

struct Unit { int pm, pn; };
struct Gemm { const bf16_t* A; const bf16_t* Bt; int M, N, K; };

struct StaticOrder {
    int nM, nN, nwg, G, c;
    __host__ __device__ void init(int M, int N, int G_, int c_) { nM = M / BM; nN = N / BM; nwg = nM * nN; G = G_; c = c_; }
    __host__ __device__ bool next(int i, Unit& u) const {
        const long L = (long)i * G + c; if (L >= nwg) return false;
        int wgid = (int)L; { const int q = nwg / NXCD, r = nwg % NXCD, xcd = wgid % NXCD, off = wgid / NXCD; wgid = (xcd < r ? xcd * (q + 1) : r * (q + 1) + (xcd - r) * q) + off; }
        const int nig = WGM * nN, gid = wgid / nig, fm = gid * WGM, gsz = (nM - fm) < WGM ? (nM - fm) : WGM;
        u.pm = fm + ((wgid % nig) % gsz); u.pn = (wgid % nig) / gsz; return true;
    }
    __device__ __forceinline__ void a_ready(const Unit&) const {}
    __device__ __forceinline__ void done(const Unit&) const {}
};

typedef float f32x2_cv __attribute__((ext_vector_type(2))); typedef __bf16 bf16x2_cv __attribute__((ext_vector_type(2)));
__device__ __forceinline__ unsigned cvt_pk_bf16(float lo, float hi) { const f32x2_cv v = {lo, hi}; const bf16x2_cv b = __builtin_convertvector(v, bf16x2_cv); return __builtin_bit_cast(unsigned, b); }
template <class Epi, class Sched, bool ALIGN_EPI = false, bool SP2 = false>
__device__ __forceinline__ void gemm_phase(PG8_LAS unsigned char* lds, const Gemm g, const Sched& S, const Epi& E) {
    const int tid = threadIdx.x, wid = __builtin_amdgcn_readfirstlane(tid >> 6), lane = tid & 63, wr = wid >> 2, wc = wid & 3, fr = lane & 15, fq = lane >> 4;
    const int K = g.K, nt = K / BK;
    unsigned voffA[2], voffB[2];
#pragma unroll
    for (int i = 0; i < 2; ++i) { int R, C; stage_rc(tid * 16 + i * 8192, R, C); const int Rb = Epi::PERM ? ((R & ~31) + perm32(R & 31)) : R;
        voffA[i] = (unsigned)(R * K + C) * 2u; voffB[i] = (unsigned)(Rb * K + C) * 2u; }
    const size_t kstep = (size_t)(BK * 2);
    const size_t hstep = (size_t)HALF * K * 2;
    const size_t tstep = 2 * hstep;
    const unsigned ldsw = (unsigned)wid * 1024u;
    const int aoff = lds_byte(wr * 64 + fr, fq * 8), boff = lds_byte(wc * 32 + fr, fq * 8);
#define PG8_SA(b, h) (((b) * 2 + (h)) * HTB)
#define PG8_SB(b, h) ((4 + (b) * 2 + (h)) * HTB)
#define PG8_STAGE(bufoff, gbase, voff) do { _Pragma("unroll") for (int _i = 0; _i < 2; ++_i) \
        __builtin_amdgcn_global_load_lds((const unsigned*)((const char*)(gbase) + (voff)[_i]), (PG8_LAS unsigned*)(lds + (bufoff) + ldsw + _i * 8192), 16, 0, 0); } while (0)
#define PG8_LDA(dst, b, h) do { _Pragma("unroll") for (int m = 0; m < 4; ++m) _Pragma("unroll") for (int k = 0; k < 2; ++k) dst[m][k] = *(const PG8_LAS bf16x8*)(lds + PG8_SA(b, h) + aoff + m * 2048 + k * 1024); } while (0)
#define PG8_LDB(dst, b, h) do { _Pragma("unroll") for (int n = 0; n < 2; ++n) _Pragma("unroll") for (int k = 0; k < 2; ++k) dst[n][k] = *(const PG8_LAS bf16x8*)(lds + PG8_SB(b, h) + boff + n * 2048 + k * 1024); } while (0)
#define PG8_MMA(ai, bj, At, Bt) do { __builtin_amdgcn_s_setprio(1); _Pragma("unroll") for (int m = 0; m < 4; ++m) _Pragma("unroll") for (int n = 0; n < 2; ++n) _Pragma("unroll") for (int k = 0; k < 2; ++k) \
        acc[ai][bj][m][n] = __builtin_amdgcn_mfma_f32_16x16x32_bf16(Bt[n][k], At[m][k], acc[ai][bj][m][n], 0, 0, 0); __builtin_amdgcn_s_setprio(0); } while (0)
#define PG8_WAIT_V(n) asm volatile("s_waitcnt vmcnt(" #n ")" ::: "memory")
#define PG8_WAIT_L(n) asm volatile("s_waitcnt lgkmcnt(" #n ")" ::: "memory")
#define PG8_BAR __builtin_amdgcn_s_barrier()
#define PG8_SCHED __builtin_amdgcn_sched_barrier(0)
    Unit cur, nxt; int ui = 0;
    if (!S.next(0, cur)) return;
    f32x4 acc[2][2][4][2];
#pragma unroll
    for (int a = 0; a < 2; ++a)
#pragma unroll
        for (int b = 0; b < 2; ++b)
#pragma unroll
            for (int m = 0; m < 4; ++m)
#pragma unroll
                for (int n = 0; n < 2; ++n) acc[a][b][m][n] = (f32x4){0.f, 0.f, 0.f, 0.f};
    bf16x8 At[4][2], B0[2][2], B1[2][2];
    const char* cA = (const char*)g.A + (size_t)cur.pm * tstep; const char* cB = (const char*)g.Bt + (size_t)cur.pn * tstep;
    S.a_ready(cur);
    if constexpr (SP2) {
        PG8_STAGE(PG8_SB(0, 0), cB, voffB); PG8_STAGE(PG8_SB(0, 1), cB + hstep, voffB); PG8_STAGE(PG8_SA(0, 0), cA, voffA); PG8_STAGE(PG8_SA(0, 1), cA + hstep, voffA);
        if (wr == 1) PG8_BAR;
        PG8_WAIT_V(2); PG8_BAR;
        PG8_STAGE(PG8_SB(1, 0), cB + kstep, voffB); PG8_STAGE(PG8_SA(1, 0), cA + kstep, voffA); PG8_STAGE(PG8_SB(1, 1), cB + hstep + kstep, voffB);
        PG8_WAIT_V(6); PG8_BAR;
    } else {
        PG8_STAGE(PG8_SB(0, 0), cB, voffB); PG8_STAGE(PG8_SA(0, 0), cA, voffA); PG8_STAGE(PG8_SB(0, 1), cB + hstep, voffB); PG8_STAGE(PG8_SA(0, 1), cA + hstep, voffA);
        if (wr == 1) PG8_BAR;
        PG8_WAIT_V(4); PG8_BAR;
        PG8_STAGE(PG8_SB(1, 0), cB + kstep, voffB); PG8_STAGE(PG8_SA(1, 0), cA + kstep, voffA); PG8_STAGE(PG8_SB(1, 1), cB + hstep + kstep, voffB);
        PG8_WAIT_V(6); PG8_BAR;
    }
    for (;;) {
        const bool has_next = S.next(ui + 1, nxt);
        const char* nA = has_next ? (const char*)g.A + (size_t)nxt.pm * tstep : cA; const char* nB = has_next ? (const char*)g.Bt + (size_t)nxt.pn * tstep : cB;
        for (int t = 0; t < nt; t += 2) {
            const bool last = (t == nt - 2);
            const char* a1 = cA + (size_t)(t + 1) * kstep;
            const char* a2 = last ? nA : cA + (size_t)(t + 2) * kstep; const char* b2 = last ? nB : cB + (size_t)(t + 2) * kstep;
            const char* a3 = a2 + kstep; const char* b3 = b2 + kstep;
            if (last && has_next) S.a_ready(nxt);
            if constexpr (SP2) {
            PG8_LDB(B0, 0, 0); PG8_LDB(B1, 0, 1); PG8_SCHED; PG8_LDA(At, 0, 0); PG8_STAGE(PG8_SA(1, 1), a1 + hstep, voffA);
            PG8_WAIT_V(8); PG8_WAIT_L(0); PG8_BAR; PG8_MMA(0, 0, At, B0); PG8_MMA(0, 1, At, B1); PG8_BAR; PG8_SCHED;
            PG8_LDA(At, 0, 1); PG8_STAGE(PG8_SB(0, 0), b2, voffB); PG8_STAGE(PG8_SB(0, 1), b2 + hstep, voffB); PG8_STAGE(PG8_SA(0, 0), a2, voffA);
            PG8_WAIT_V(8); PG8_WAIT_L(0); PG8_BAR; PG8_MMA(1, 0, At, B0); PG8_MMA(1, 1, At, B1); PG8_BAR; PG8_SCHED;
            PG8_LDB(B0, 1, 0); PG8_LDB(B1, 1, 1); PG8_SCHED; PG8_LDA(At, 1, 0); PG8_STAGE(PG8_SA(0, 1), a2 + hstep, voffA);
            PG8_WAIT_V(8); PG8_WAIT_L(0); PG8_BAR; PG8_MMA(0, 0, At, B0); PG8_MMA(0, 1, At, B1); PG8_BAR; PG8_SCHED;
            PG8_LDA(At, 1, 1); PG8_STAGE(PG8_SB(1, 0), b3, voffB); PG8_STAGE(PG8_SB(1, 1), b3 + hstep, voffB); PG8_STAGE(PG8_SA(1, 0), a3, voffA);
            PG8_WAIT_V(8); PG8_WAIT_L(0); PG8_BAR; PG8_MMA(1, 0, At, B0); PG8_MMA(1, 1, At, B1); PG8_BAR; PG8_SCHED;
            } else {
            PG8_LDB(B0, 0, 0); PG8_SCHED; PG8_LDA(At, 0, 0); PG8_STAGE(PG8_SA(1, 1), a1 + hstep, voffA);
            PG8_WAIT_L(8); PG8_BAR; PG8_WAIT_L(0); PG8_MMA(0, 0, At, B0); PG8_BAR; PG8_SCHED;
            PG8_LDB(B1, 0, 1); PG8_STAGE(PG8_SB(0, 0), b2, voffB);
            PG8_BAR; PG8_WAIT_L(0); PG8_MMA(0, 1, At, B1); PG8_BAR;
            PG8_LDA(At, 0, 1); PG8_STAGE(PG8_SA(0, 0), a2, voffA);
            PG8_BAR; PG8_WAIT_L(0); PG8_MMA(1, 0, At, B0); PG8_BAR; PG8_SCHED;
            PG8_STAGE(PG8_SB(0, 1), b2 + hstep, voffB);
            PG8_WAIT_V(6); PG8_BAR; PG8_MMA(1, 1, At, B1); PG8_BAR;
            PG8_LDB(B0, 1, 0); PG8_SCHED; PG8_LDA(At, 1, 0); PG8_STAGE(PG8_SA(0, 1), a2 + hstep, voffA);
            PG8_WAIT_L(8); PG8_BAR; PG8_WAIT_L(0); PG8_MMA(0, 0, At, B0); PG8_BAR; PG8_SCHED;
            PG8_LDB(B1, 1, 1); PG8_STAGE(PG8_SB(1, 0), b3, voffB);
            PG8_BAR; PG8_WAIT_L(0); PG8_MMA(0, 1, At, B1); PG8_BAR;
            PG8_LDA(At, 1, 1); PG8_STAGE(PG8_SA(1, 0), a3, voffA);
            PG8_BAR; PG8_WAIT_L(0); PG8_MMA(1, 0, At, B0); PG8_BAR; PG8_SCHED;
            PG8_STAGE(PG8_SB(1, 1), b3 + hstep, voffB);
            PG8_WAIT_V(6); PG8_BAR; PG8_MMA(1, 1, At, B1); PG8_BAR;
            }
        }
        if constexpr (ALIGN_EPI) { if (wr == 0) PG8_BAR; }
        if constexpr (!Epi::AFTER_DRAIN) { E(acc, cur, wr, wc, fr, fq); S.done(cur); }
        if (!has_next) break;
#pragma unroll
        for (int a = 0; a < 2; ++a)
#pragma unroll
            for (int b = 0; b < 2; ++b)
#pragma unroll
                for (int m = 0; m < 4; ++m)
#pragma unroll
                    for (int n = 0; n < 2; ++n) acc[a][b][m][n] = (f32x4){0.f, 0.f, 0.f, 0.f};
        cur = nxt; cA = nA; cB = nB; ++ui;
        if constexpr (ALIGN_EPI) { if (wr == 1) PG8_BAR; }
    }
    PG8_WAIT_V(0);
    if constexpr (!ALIGN_EPI) { if (wr == 0) PG8_BAR; }
    PG8_BAR;
    if constexpr (Epi::AFTER_DRAIN) { E.fused(acc, cur, wr, wc, fr, fq, lds, wid, lane); S.done(cur); }
#undef PG8_SA
#undef PG8_SB
#undef PG8_STAGE
#undef PG8_LDA
#undef PG8_LDB
#undef PG8_MMA
#undef PG8_WAIT_V
#undef PG8_WAIT_L
#undef PG8_BAR
#undef PG8_SCHED
}
}

using pg8::bf16_t; using pg8::bf16x8; using pg8::f32x4; using pg8::u32x4; using pg8::Unit; using pg8::cvt_pk_bf16;
#define LAS __attribute__((address_space(3)))
typedef LAS unsigned char* ldsp;
typedef unsigned u32x2 __attribute__((ext_vector_type(2)));
typedef float f32x2v __attribute__((ext_vector_type(2)));

constexpr int M_TOK = 16384, DM = 2048, SEQ = 2048, ZW = 7168, INW = 7184, INW_PAD = 7424, FFH = 5632, QKVW = 6144;
constexpr float EPS = 1e-6f;
constexpr size_t MiB = 1u << 20;
constexpr size_t WS_SS = 0, WS_GLR = 1 * MiB, WS_LSE = 2 * MiB, WS_ROPE = 5 * MiB, WS_PB = 21 * MiB, WS_WIN = 37 * MiB, WS_WOUT = 67 * MiB, WS_WGU = 75 * MiB,
                 WS_WD = 119 * MiB, WS_WPG = 141 * MiB, WS_WPP = 149 * MiB, WS_XB0 = 150 * MiB, WS_XB1 = 214 * MiB, WS_O = 278 * MiB, WS_Z = 342 * MiB, WS_END = 566 * MiB;
constexpr int LDS_BYTES = 160 * 1024;

__device__ __forceinline__ float bf2f(unsigned h) { return __uint_as_float(h << 16); }
__device__ __forceinline__ float bflo(unsigned w) { return __uint_as_float(w << 16); }
__device__ __forceinline__ float bfhi(unsigned w) { return __uint_as_float(w & 0xffff0000u); }
__device__ __forceinline__ unsigned short f2bf(float f) { return (unsigned short)(cvt_pk_bf16(f, 0.f) & 0xffffu); }
__device__ __forceinline__ float fast_rcp(float x) { return __builtin_amdgcn_rcpf(x); }
__device__ __forceinline__ float silu_f(float x) { return x * fast_rcp(1.f + __expf(-x)); }
__device__ __forceinline__ float sigmoid_f(float x) { return fast_rcp(1.f + __expf(-x)); }
__device__ __forceinline__ float rstd_of(float ss, float inv_n) { return rsqrtf(ss * inv_n + EPS); }
#define LDS_WAIT() asm volatile("s_waitcnt lgkmcnt(0)" ::: "memory")

struct EpiProj {
    static constexpr bool PERM = true, AFTER_DRAIN = false;
    int mode; bf16_t* O; int ldo; float* GLR; const float* ss; const f32x4* rope;
    __device__ __forceinline__ void operator()(const f32x4 (&acc)[2][2][4][2], const Unit& u, int wr, int wc, int fr, int fq) const {
        const int pn = u.pn;
        float rs[2][4];
#pragma unroll
        for (int ai = 0; ai < 2; ++ai)
#pragma unroll
            for (int m = 0; m < 4; ++m) { rs[ai][m] = 1.f; if (mode != 2) rs[ai][m] = ss[u.pm * 256 + ai * 128 + wr * 64 + m * 16 + fr]; }
        const bool rot = (mode == 0) && (pn < 8);
#pragma unroll
        for (int aig = 0; aig < 4; ++aig) { const int ai = aig >> 1, mg = (aig & 1) * 2;
            f32x4 rp[4][2][2];
            if (rot) {
#pragma unroll
                for (int m = mg; m < mg + 2; ++m)
#pragma unroll
                    for (int bj = 0; bj < 2; ++bj) { const int row = u.pm * 256 + ai * 128 + wr * 64 + m * 16 + fr, col0 = pn * 256 + bj * 128 + wc * 32 + 8 * fq;
                        const f32x4* p_ = rope + (size_t)row * 64 + ((col0 & 255) >> 2); rp[m][bj][0] = p_[0]; rp[m][bj][1] = p_[1]; }
            }
#pragma unroll
            for (int m = mg; m < mg + 2; ++m) {
                const int row = u.pm * 256 + ai * 128 + wr * 64 + m * 16 + fr;
                float r_ = 1.f; if (mode != 2) r_ = rstd_of(rs[ai][m], 1.f / 2048.f);
#pragma unroll
                for (int bj = 0; bj < 2; ++bj) {
                    const int col0 = pn * 256 + bj * 128 + wc * 32 + 8 * fq;
                    f32x4 v0 = acc[ai][bj][m][0] * r_, v1 = acc[ai][bj][m][1] * r_;
                    if (mode == 0) {
                        if (pn < 8) {
                            const f32x4 c01 = rp[m][bj][0], c23 = rp[m][bj][1];
                            f32x4 r0, r1;
                            r0[0] = v0[0] * c01[0] - v0[1] * c01[1]; r0[1] = v0[0] * c01[1] + v0[1] * c01[0];
                            r0[2] = v0[2] * c01[2] - v0[3] * c01[3]; r0[3] = v0[2] * c01[3] + v0[3] * c01[2];
                            r1[0] = v1[0] * c23[0] - v1[1] * c23[1]; r1[1] = v1[0] * c23[1] + v1[1] * c23[0];
                            r1[2] = v1[2] * c23[2] - v1[3] * c23[3]; r1[3] = v1[2] * c23[3] + v1[3] * c23[2];
                            v0 = r0; v1 = r1;
                            if (pn >= 4) { v0 = v0 * 0.0625f; v1 = v1 * 0.0625f; }
                        } else if (pn == 16 || pn == 17) { v0 = v0 * 0.08838834764831845f; v1 = v1 * 0.08838834764831845f; }
                    } else if (mode == 1) { if (pn < 8) { v0 = v0 * 0.08838834764831845f; v1 = v1 * 0.08838834764831845f; } }
                    if (mode == 0 && pn == 28) {
                        if (bj == 0 && wc == 0 && fq < 2) { *(f32x4*)(GLR + (size_t)row * 16 + 8 * fq) = v0; *(f32x4*)(GLR + (size_t)row * 16 + 8 * fq + 4) = v1; }
                    } else {
                        u32x4 w; w.x = cvt_pk_bf16(v0[0], v0[1]); w.y = cvt_pk_bf16(v0[2], v0[3]); w.z = cvt_pk_bf16(v1[0], v1[1]); w.w = cvt_pk_bf16(v1[2], v1[3]);
                        *(u32x4*)(O + (size_t)row * ldo + col0) = w;
                    }
                }
            }
        }
    }
};
struct EpiSwiglu {
    static constexpr bool PERM = true, AFTER_DRAIN = false;
    bf16_t* ACT; const float* ss;
    __device__ __forceinline__ void operator()(const f32x4 (&acc)[2][2][4][2], const Unit& u, int wr, int wc, int fr, int fq) const {
        float rsv[2][4];
#pragma unroll
        for (int ai = 0; ai < 2; ++ai)
#pragma unroll
            for (int m = 0; m < 4; ++m) rsv[ai][m] = ss[u.pm * 256 + ai * 128 + wr * 64 + m * 16 + fr];
#pragma unroll
        for (int ai = 0; ai < 2; ++ai)
#pragma unroll
            for (int m = 0; m < 4; ++m) {
                const int row = u.pm * 256 + ai * 128 + wr * 64 + m * 16 + fr;
                const float rs = rstd_of(rsv[ai][m], 1.f / 2048.f);
                float o[8];
#pragma unroll
                for (int n = 0; n < 2; ++n)
#pragma unroll
                    for (int j = 0; j < 4; ++j) { const float g = acc[ai][0][m][n][j] * rs, up = acc[ai][1][m][n][j] * rs; o[n * 4 + j] = silu_f(g) * up; }
                u32x4 w; w.x = cvt_pk_bf16(o[0], o[1]); w.y = cvt_pk_bf16(o[2], o[3]); w.z = cvt_pk_bf16(o[4], o[5]); w.w = cvt_pk_bf16(o[6], o[7]);
                *(u32x4*)(ACT + (size_t)row * FFH + u.pn * 128 + wc * 32 + 8 * fq) = w;
            }
    }
};
struct EpiRes {
    static constexpr bool PERM = true, AFTER_DRAIN = false;
    int ple; const bf16_t* base; bf16_t* xb; float* ss_out; const float* ss_in; const bf16_t* pp;
    __device__ __forceinline__ void operator()(const f32x4 (&acc)[2][2][4][2], const Unit& u, int wr, int wc, int fr, int fq) const {
        float rsv[2][4];
#pragma unroll
        for (int ai = 0; ai < 2; ++ai)
#pragma unroll
            for (int m = 0; m < 4; ++m) { rsv[ai][m] = 0.f; if (ple) rsv[ai][m] = ss_in[u.pm * 256 + ai * 128 + wr * 64 + m * 16 + fr]; }
#pragma unroll
        for (int aig = 0; aig < 4; ++aig) { const int ai = aig >> 1, mg = (aig & 1) * 2;
            u32x4 bwv[4][2], pwv[4][2];
#pragma unroll
            for (int m = mg; m < mg + 2; ++m)
#pragma unroll
                for (int bj = 0; bj < 2; ++bj) { const size_t off = (size_t)(u.pm * 256 + ai * 128 + wr * 64 + m * 16 + fr) * DM + u.pn * 256 + bj * 128 + wc * 32 + 8 * fq;
                    bwv[m][bj] = *(const u32x4*)(base + off); pwv[m][bj] = (u32x4){0u, 0u, 0u, 0u}; if (ple) pwv[m][bj] = *(const u32x4*)(pp + off); }
#pragma unroll
            for (int m = mg; m < mg + 2; ++m) {
                const int row = u.pm * 256 + ai * 128 + wr * 64 + m * 16 + fr;
                float rs = 1.f; if (ple) rs = rstd_of(rsv[ai][m], 1.f / 2048.f);
                float sq = 0.f;
#pragma unroll
                for (int bj = 0; bj < 2; ++bj) {
                    const size_t off = (size_t)row * DM + u.pn * 256 + bj * 128 + wc * 32 + 8 * fq;
                    const u32x4 bw = bwv[m][bj];
                    float v[8] = {acc[ai][bj][m][0][0], acc[ai][bj][m][0][1], acc[ai][bj][m][0][2], acc[ai][bj][m][0][3], acc[ai][bj][m][1][0], acc[ai][bj][m][1][1], acc[ai][bj][m][1][2], acc[ai][bj][m][1][3]};
                    if (ple) { const u32x4 pw = pwv[m][bj];
                        const float pf[8] = {bflo(pw.x), bfhi(pw.x), bflo(pw.y), bfhi(pw.y), bflo(pw.z), bfhi(pw.z), bflo(pw.w), bfhi(pw.w)};
#pragma unroll
                        for (int j = 0; j < 8; ++j) v[j] = sigmoid_f(v[j] * rs) * pf[j]; }
                    const float bf[8] = {bflo(bw.x), bfhi(bw.x), bflo(bw.y), bfhi(bw.y), bflo(bw.z), bfhi(bw.z), bflo(bw.w), bfhi(bw.w)};
#pragma unroll
                    for (int j = 0; j < 8; ++j) { v[j] += bf[j]; sq += v[j] * v[j]; }
                    u32x4 w; w.x = cvt_pk_bf16(v[0], v[1]); w.y = cvt_pk_bf16(v[2], v[3]); w.z = cvt_pk_bf16(v[4], v[5]); w.w = cvt_pk_bf16(v[6], v[7]);
                    *(u32x4*)(xb + off) = w;
                }
                sq += __shfl_xor(sq, 16); sq += __shfl_xor(sq, 32);
                if (fq == 0) unsafeAtomicAdd(ss_out + row, sq);
            }
        }
    }
};

__device__ __forceinline__ void conv_weight(LAS unsigned* scr, const float* W, int K, int N, bf16_t* WT, const float* kscale, int mode, int first, int ngw, int lane) {
    const int nblk = (N + 63) >> 6, nitems = nblk * (K >> 6);
    const int g = lane >> 4, n4 = (lane & 15) * 4;
    for (int it = first; it < nitems; it += ngw) {
        const int kb = it / nblk, nb = it - kb * nblk, k0 = kb << 6, n0 = nb << 6;
        const bool ok = (n0 + n4) < N;
        f32x4 v[16];
#pragma unroll
        for (int i = 0; i < 16; ++i) { const int k = 8 * (i >> 1) + 2 * g + (i & 1); v[i] = (f32x4){0.f, 0.f, 0.f, 0.f}; if (ok) v[i] = *(const f32x4*)(W + (size_t)(k0 + k) * N + n0 + n4); }
        if (kscale) {
#pragma unroll
            for (int i = 0; i < 16; ++i) { const int k = 8 * (i >> 1) + 2 * g + (i & 1); v[i] = v[i] * kscale[k0 + k]; } }
#pragma unroll
        for (int m = 0; m < 8; ++m)
#pragma unroll
            for (int j = 0; j < 4; ++j) scr[(n4 + j) * 33 + 4 * m + g] = cvt_pk_bf16(v[2 * m][j], v[2 * m + 1][j]);
        LDS_WAIT();
        const int c = lane & 7;
#pragma unroll
        for (int jr = 0; jr < 8; ++jr) { const int nl = (lane >> 3) + 8 * jr, n = n0 + nl; const LAS unsigned* sp = scr + nl * 33 + 4 * c;
            const u32x4 o = {sp[0], sp[1], sp[2], sp[3]};
            int dr = n; if (mode == 1) dr = ((n >> 7) << 8) + (n & 127); else if (mode == 2) dr = ((n >> 7) << 8) + 128 + (n & 127);
            if (n < N) *(u32x4*)(WT + (size_t)dr * K + k0 + 8 * c) = o; }
        LDS_WAIT();
    }
}

typedef short v4i16_t __attribute__((ext_vector_type(4)));
__device__ __forceinline__ u32x2 lds_tr16(const LAS bf16_t* p) { return __builtin_bit_cast(u32x2, __builtin_amdgcn_ds_read_tr16_b64_v4i16((LAS v4i16_t*)p)); }
#define LBAR() do { asm volatile("s_waitcnt lgkmcnt(0)" ::: "memory"); __builtin_amdgcn_s_barrier(); asm volatile("" ::: "memory"); } while (0)
template <int DK, bool GLA>
__device__ __forceinline__ void mixer_unit(ldsp lds, int b, int h, int es, const bf16_t* Z, const float* GLR, const float* gate_up, const float* gate_b, bf16_t* Oraw, int tid) {
    constexpr int LQ = DK + 16, LT = 72, LVM = 80, NP = DK / 64, PPR = DK / 8, NT = DK / 32;
    constexpr int OFF_Q = 0, OFF_K = OFF_Q + 64 * LQ * 2, OFF_ST = OFF_K + 64 * LQ * 2, OFF_V = OFF_ST + 64 * LQ * 2, OFF_VD = OFF_V + 64 * LVM * 2, OFF_S = OFF_VD + 64 * LVM * 2, OFF_X = OFF_S + 64 * LT * 2;
    constexpr int OFF_CUM = OFF_X, OFF_SEGT = OFF_CUM + 64 * 128 * 4, OFF_EL = OFF_SEGT + 4 * 128 * 4, OFF_GLR = OFF_EL + 128 * 4, OFF_GU = OFF_GLR + 64 * 16 * 4, OFF_GB = OFF_GU + 16 * 128 * 4, OFF_ENDX = OFF_GB + 128 * 4;
    static_assert((GLA ? OFF_ENDX : OFF_X) <= LDS_BYTES, "mixer LDS");
    const int w = __builtin_amdgcn_readfirstlane(tid >> 6), lane = tid & 63, fr = lane & 15, fq = lane >> 4;
    const int qoff = GLA ? 4096 + h * 128 : h * 256, koff = GLA ? 4608 + h * 128 : 1024 + h * 256, voff = (GLA ? 5120 : 2048) + h * 256 + es * 64, ocol = (GLA ? 1024 : 0) + h * 256 + es * 64;
    const float lg = (h == 0) ? -0.0317486983145803f : (h == 1) ? -0.015748356968139168f : (h == 2) ? -0.007843177461025893f : -0.003913899321136329f;
    LAS bf16_t* Qs = (LAS bf16_t*)(lds + OFF_Q); LAS bf16_t* Ks = (LAS bf16_t*)(lds + OFF_K); LAS bf16_t* Vds = (LAS bf16_t*)(lds + OFF_VD);
    LAS bf16_t* Vs = (LAS bf16_t*)(lds + OFF_V); LAS bf16_t* Ss = (LAS bf16_t*)(lds + OFF_S); LAS bf16_t* STs = (LAS bf16_t*)(lds + OFF_ST);
    LAS float* CUM = (LAS float*)(lds + OFF_CUM); LAS float* SEGT = (LAS float*)(lds + OFF_SEGT); LAS float* EL = (LAS float*)(lds + OFF_EL);
    LAS float* GLRs = (LAS float*)(lds + OFF_GLR); LAS float* GU = (LAS float*)(lds + OFF_GU); LAS float* GB = (LAS float*)(lds + OFF_GB);
    for (int i = tid; i < 64 * LQ * 2 / 16; i += 512) ((LAS u32x4*)STs)[i] = (u32x4){0u, 0u, 0u, 0u};
    if (GLA) { for (int i = tid; i < 16 * 128; i += 512) GU[i] = gate_up[(size_t)(i >> 7) * 512 + h * 128 + (i & 127)]; if (tid < 128) GB[tid] = gate_b[h * 128 + tid]; }
    f32x4 st[NT];
#pragma unroll
    for (int t = 0; t < NT; ++t) st[t] = (f32x4){0.f, 0.f, 0.f, 0.f};
    u32x4 rq[NP], rk[NP], rv;
    const int vrow = tid >> 3, vpc = tid & 7;
    {   const size_t tb = (size_t)b * SEQ;
#pragma unroll
        for (int i = 0; i < NP; ++i) { const int p = tid + 512 * i, row = p / PPR, pc = p % PPR; rq[i] = *(const u32x4*)(Z + (tb + row) * ZW + qoff + pc * 8); rk[i] = *(const u32x4*)(Z + (tb + row) * ZW + koff + pc * 8); }
        rv = *(const u32x4*)(Z + (tb + vrow) * ZW + voff + vpc * 8); }
    const int te = w & 3, ti0 = (w >> 2) * 2;
    const int tis = w >> 1, tj0 = (w & 1) * 2;
    const int tdb = (w >> 2) * NT;
    const int trq = fr >> 2, trp = fr & 3;
    float guv[16], gbv = 0.f; f32x2v rg = {0.f, 0.f};
    if (GLA) {
        rg = *(const f32x2v*)(GLR + (size_t)b * SEQ * 16 + tid * 2);
        *(LAS f32x2v*)(GLRs + tid * 2) = rg;
        LBAR();
#pragma unroll
        for (int r = 0; r < 16; ++r) guv[r] = GU[r * 128 + (tid & 127)];
        gbv = GB[tid & 127];
        {   const int d = tid & 127, seg = tid >> 7; float run = 0.f;
#pragma unroll 4
            for (int jj = 0; jj < 16; ++jj) { const int j = seg * 16 + jj; f32x2v ua2 = {gbv, 0.f};
#pragma unroll
                    for (int r = 0; r < 16; r += 2) { const f32x2v g2 = *(const LAS f32x2v*)(GLRs + j * 16 + r); ua2 += g2 * (f32x2v){guv[r], guv[r + 1]}; }
                    const float uacc = ua2.x + ua2.y;
                run += (fminf(uacc, 0.f) - __logf(1.f + __expf(-fabsf(uacc)))) * 0.0625f; CUM[j * 128 + d] = run; }
            SEGT[seg * 128 + d] = run; }
        rg = *(const f32x2v*)(GLR + ((size_t)b * SEQ + 64) * 16 + tid * 2);
        LBAR();
    } else {
#pragma unroll
        for (int r = 0; r < 16; ++r) guv[r] = 0.f; }
    for (int c = 0; c < 32; ++c) {
        const size_t tb = (size_t)b * SEQ + (size_t)c * 64;
        if (GLA) {
            if (c < 31) *(LAS f32x2v*)(GLRs + tid * 2) = rg;
            {   const int d = tid & 127, seg = tid >> 7; float off = 0.f;
                if (seg > 0) off += SEGT[d]; if (seg > 1) off += SEGT[128 + d]; if (seg > 2) off += SEGT[256 + d];
                if (seg > 0) {
#pragma unroll
                    for (int jj = 0; jj < 16; ++jj) CUM[(seg * 16 + jj) * 128 + d] += off; }
                if (seg == 3) EL[d] = __expf(CUM[63 * 128 + d]); }
            LBAR();
        }
#pragma unroll
        for (int i = 0; i < NP; ++i) { const int p = tid + 512 * i, row = p / PPR, pc = p % PPR;
            const unsigned qw[4] = {rq[i].x, rq[i].y, rq[i].z, rq[i].w}, kw[4] = {rk[i].x, rk[i].y, rk[i].z, rk[i].w};
            if (GLA) {
                unsigned qo[4], ko[4];
#pragma unroll
                for (int jj = 0; jj < 4; ++jj) { const int d = pc * 8 + 2 * jj;
                    const float c0 = CUM[row * 128 + d], c1 = CUM[row * 128 + d + 1], l0 = CUM[63 * 128 + d], l1 = CUM[63 * 128 + d + 1];
                    const float e0 = __expf(c0), e1 = __expf(c1), k0 = bflo(kw[jj]), k1 = bfhi(kw[jj]);
                    qo[jj] = cvt_pk_bf16(bflo(qw[jj]) * e0, bfhi(qw[jj]) * e1);
                    ko[jj] = cvt_pk_bf16(k0 * fast_rcp(e0), k1 * fast_rcp(e1));
                }
                *(LAS u32x4*)(Qs + row * LQ + pc * 8) = (u32x4){qo[0], qo[1], qo[2], qo[3]};
                *(LAS u32x4*)(Ks + row * LQ + pc * 8) = (u32x4){ko[0], ko[1], ko[2], ko[3]};
            } else {
                *(LAS u32x4*)(Qs + row * LQ + pc * 8) = rq[i];
                *(LAS u32x4*)(Ks + row * LQ + pc * 8) = rk[i];
            } }
        *(LAS u32x4*)(Vs + vrow * LVM + vpc * 8) = rv;
        if (!GLA) {
            const float kd = __expf((float)(63 - vrow) * lg);
            *(LAS u32x4*)(Vds + vrow * LVM + vpc * 8) = (u32x4){cvt_pk_bf16(bflo(rv.x) * kd, bfhi(rv.x) * kd), cvt_pk_bf16(bflo(rv.y) * kd, bfhi(rv.y) * kd), cvt_pk_bf16(bflo(rv.z) * kd, bfhi(rv.z) * kd), cvt_pk_bf16(bflo(rv.w) * kd, bfhi(rv.w) * kd)}; }
        LBAR();
        if (c < 31) { const size_t tn = tb + 64;
#pragma unroll
            for (int i = 0; i < NP; ++i) { const int p = tid + 512 * i, row = p / PPR, pc = p % PPR; rq[i] = *(const u32x4*)(Z + (tn + row) * ZW + qoff + pc * 8); rk[i] = *(const u32x4*)(Z + (tn + row) * ZW + koff + pc * 8); }
            rv = *(const u32x4*)(Z + (tn + vrow) * ZW + voff + vpc * 8);
        }
        if (GLA && c < 30) rg = *(const f32x2v*)(GLR + (tb + 128) * 16 + tid * 2);
        f32x4 o2a = {0.f, 0.f, 0.f, 0.f}, o2b = {0.f, 0.f, 0.f, 0.f};
        {   f32x4 s0 = {0.f, 0.f, 0.f, 0.f}, s1 = {0.f, 0.f, 0.f, 0.f};
#pragma unroll
            for (int ks = 0; ks < NT; ++ks) {
                const bf16x8 a = *(const LAS bf16x8*)(Qs + (16 * tis + fr) * LQ + 32 * ks + 8 * fq);
                const bf16x8 b0 = *(const LAS bf16x8*)(Ks + (16 * tj0 + fr) * LQ + 32 * ks + 8 * fq), b1 = *(const LAS bf16x8*)(Ks + (16 * tj0 + 16 + fr) * LQ + 32 * ks + 8 * fq);
                s0 = __builtin_amdgcn_mfma_f32_16x16x32_bf16(a, b0, s0, 0, 0, 0); s1 = __builtin_amdgcn_mfma_f32_16x16x32_bf16(a, b1, s1, 0, 0, 0);
                const bf16x8 sa = *(const LAS bf16x8*)(STs + (16 * te + fr) * LQ + 32 * ks + 8 * fq);
                const bf16x8 q0 = *(const LAS bf16x8*)(Qs + (16 * ti0 + fr) * LQ + 32 * ks + 8 * fq), q1 = *(const LAS bf16x8*)(Qs + (16 * ti0 + 16 + fr) * LQ + 32 * ks + 8 * fq);
                o2a = __builtin_amdgcn_mfma_f32_16x16x32_bf16(sa, q0, o2a, 0, 0, 0); o2b = __builtin_amdgcn_mfma_f32_16x16x32_bf16(sa, q1, o2b, 0, 0, 0);
            }
#pragma unroll
            for (int r = 0; r < 4; ++r) { const int i = 16 * tis + 4 * fq + r, j = 16 * tj0 + fr;
                float m0, m1;
                if (GLA) { m0 = (i >= j) ? 1.f : 0.f; m1 = (i >= j + 16) ? 1.f : 0.f; }
                else { m0 = (i >= j) ? __expf((float)(i - j) * lg) : 0.f; m1 = (i >= j + 16) ? __expf((float)(i - j - 16) * lg) : 0.f; }
                Ss[i * LT + j] = f2bf(m0 != 0.f ? s0[r] * m0 : 0.f); Ss[i * LT + j + 16] = f2bf(m1 != 0.f ? s1[r] * m1 : 0.f); }
        }
        LBAR();
        if (GLA && c < 31) {
            {   const int d = tid & 127, seg = tid >> 7; float run = 0.f;
#pragma unroll 4
                for (int jj = 0; jj < 16; ++jj) { const int j = seg * 16 + jj; f32x2v ua2 = {gbv, 0.f};
#pragma unroll
                    for (int r = 0; r < 16; r += 2) { const f32x2v g2 = *(const LAS f32x2v*)(GLRs + j * 16 + r); ua2 += g2 * (f32x2v){guv[r], guv[r + 1]}; }
                    const float uacc = ua2.x + ua2.y;
                    run += (fminf(uacc, 0.f) - __logf(1.f + __expf(-fabsf(uacc)))) * 0.0625f; CUM[j * 128 + d] = run; }
                SEGT[seg * 128 + d] = run; }
        }
        {   f32x4 o1a = {0.f, 0.f, 0.f, 0.f}, o1b = {0.f, 0.f, 0.f, 0.f};
            bf16x8 vf[2], vdf[2];
#pragma unroll
            for (int ks = 0; ks < 2; ++ks) {
                const LAS bf16_t* vp = Vs + (32 * ks + 8 * fq + trq) * LVM + 16 * te + 4 * trp;
                const u32x2 vlo = lds_tr16(vp), vhi = lds_tr16(vp + 4 * LVM);
                vf[ks] = __builtin_bit_cast(bf16x8, (u32x4){vlo.x, vlo.y, vhi.x, vhi.y});
                if (!GLA) { const LAS bf16_t* dp = Vds + (32 * ks + 8 * fq + trq) * LVM + 16 * te + 4 * trp; const u32x2 dlo = lds_tr16(dp), dhi = lds_tr16(dp + 4 * LVM); vdf[ks] = __builtin_bit_cast(bf16x8, (u32x4){dlo.x, dlo.y, dhi.x, dhi.y}); } else vdf[ks] = vf[ks];
                const bf16x8 b0 = *(const LAS bf16x8*)(Ss + (16 * ti0 + fr) * LT + 32 * ks + 8 * fq), b1 = *(const LAS bf16x8*)(Ss + (16 * ti0 + 16 + fr) * LT + 32 * ks + 8 * fq);
                o1a = __builtin_amdgcn_mfma_f32_16x16x32_bf16(vf[ks], b0, o1a, 0, 0, 0); o1b = __builtin_amdgcn_mfma_f32_16x16x32_bf16(vf[ks], b1, o1b, 0, 0, 0);
            }
            const int ia = 16 * ti0 + fr, ib = ia + 16;
            const float qa = GLA ? 1.f : __expf((float)(ia + 1) * lg), qb = GLA ? 1.f : __expf((float)(ib + 1) * lg);
            const f32x4 oa = o1a + o2a * qa, ob = o1b + o2b * qb;
            u32x2 wa, wb; wa.x = cvt_pk_bf16(oa[0], oa[1]); wa.y = cvt_pk_bf16(oa[2], oa[3]); wb.x = cvt_pk_bf16(ob[0], ob[1]); wb.y = cvt_pk_bf16(ob[2], ob[3]);
            *(u32x2*)(Oraw + (tb + ia) * DM + ocol + 16 * te + 4 * fq) = wa;
            *(u32x2*)(Oraw + (tb + ib) * DM + ocol + 16 * te + 4 * fq) = wb;
            const float cd = __expf(64.f * lg);
#pragma unroll
            for (int t = 0; t < NT; ++t) { const int td = tdb + t;
                if (!GLA) st[t] = st[t] * cd;
#pragma unroll
                for (int ks = 0; ks < 2; ++ks) { const LAS bf16_t* kp = Ks + (32 * ks + 8 * fq + trq) * LQ + 16 * td + 4 * trp;
                    const u32x2 klo = lds_tr16(kp), khi = lds_tr16(kp + 4 * LQ);
                    st[t] = __builtin_amdgcn_mfma_f32_16x16x32_bf16(__builtin_bit_cast(bf16x8, (u32x4){klo.x, klo.y, khi.x, khi.y}), vdf[ks], st[t], 0, 0, 0); }
                if (GLA) { const f32x4 el = *(const LAS f32x4*)(EL + 16 * td + 4 * fq); st[t] = st[t] * el; }
                u32x2 sw; sw.x = cvt_pk_bf16(st[t][0], st[t][1]); sw.y = cvt_pk_bf16(st[t][2], st[t][3]);
                *(LAS u32x2*)(STs + (16 * te + fr) * LQ + 16 * td + 4 * fq) = sw; }
        }
        LBAR();
    }
}

struct AttnItem { int b, head, br, rr, c, n; };
template <int MODE> __device__ __forceinline__ AttnItem attn_decode(int item) { AttnItem t; const int per = MODE ? 16 : 32; const int bh = item / per, rem = item - bh * per, cn = rem & 15; t.br = MODE ? 2 : (rem >> 4); const int sh = 2 * t.br; t.rr = 1 << sh; t.c = cn & (t.rr - 1); t.n = cn >> sh; t.b = bh >> 4; t.head = bh & 15; return t; }
constexpr int ATT_LK = 136, ATT_LV = 144, ATT_OFF_VS = 256 * ATT_LK * 2;
static_assert(ATT_OFF_VS + 272 * ATT_LV * 2 <= LDS_BYTES, "attention LDS");
__device__ __forceinline__ void attn_load(const AttnItem& t, const bf16_t* QKV, u32x4 (&kr)[8], u32x4 (&vr)[8], int tid) {
    const size_t rowb = (size_t)t.b * SEQ;
#pragma unroll
    for (int i = 0; i < 8; ++i) { const int p = tid + 512 * i, kj = p >> 4, pc = p & 15, us = 128 * (t.n - 1) + kj;
        kr[i] = (u32x4){0u, 0u, 0u, 0u}; vr[i] = (u32x4){0u, 0u, 0u, 0u};
        if (us >= 0) { const size_t row = rowb + (size_t)us * t.rr + t.c; kr[i] = *(const u32x4*)(QKV + row * QKVW + 2048 + t.head * 128 + pc * 8); vr[i] = *(const u32x4*)(QKV + row * QKVW + 4096 + t.head * 128 + pc * 8); } }
}
template <int MODE> __device__ __forceinline__ void attn_phase(ldsp lds, const bf16_t* QKV, bf16_t* OB0, bf16_t* OB1, bf16_t* OUT, float* LSE, int tid) {
    constexpr int NITEMS = MODE ? 2048 : 4096;
    constexpr int LK = ATT_LK, LV = ATT_LV;
    const int w = __builtin_amdgcn_readfirstlane(tid >> 6), lane = tid & 63, fr = lane & 15, fq = lane >> 4;
    LAS bf16_t* Ks = (LAS bf16_t*)lds; LAS bf16_t* Vs = (LAS bf16_t*)(lds + ATT_OFF_VS);
    const int G = gridDim.x;
    int item = blockIdx.x;
    if (item >= NITEMS) return;
    if (tid < 256) *(LAS u32x4*)(Vs + (256 + (tid >> 4)) * LV + (tid & 15) * 8) = (u32x4){0u, 0u, 0u, 0u};
    u32x4 kr[8], vr[8];
    AttnItem t = attn_decode<MODE>(item);
    attn_load(t, QKV, kr, vr, tid);
    bf16x8 qn[4];
    {   const size_t qr0 = (size_t)t.b * SEQ + (size_t)(128 * t.n + 16 * w + fr) * t.rr + t.c;
#pragma unroll
        for (int ks = 0; ks < 4; ++ks) qn[ks] = *(const bf16x8*)(QKV + qr0 * QKVW + t.head * 128 + 32 * ks + 8 * fq); }
    for (;;) {
        bf16_t* OB = MODE ? OUT : (t.br == 0 ? OB0 : OB1);
        const int qi = 16 * w + fr;
        const size_t qrow = (size_t)t.b * SEQ + (size_t)(128 * t.n + qi) * t.rr + t.c;
        const int n_cur = t.n, head = t.head, br = t.br;
        bf16x8 qf[4];
#pragma unroll
        for (int ks = 0; ks < 4; ++ks) qf[ks] = qn[ks];
#pragma unroll
        for (int i = 0; i < 8; ++i) { const int p = tid + 512 * i, kj = p >> 4, pc = p & 15; *(LAS u32x4*)(Ks + kj * LK + pc * 8) = kr[i]; *(LAS u32x4*)(Vs + kj * LV + pc * 8) = vr[i]; }
        asm volatile("s_waitcnt lgkmcnt(0)" ::: "memory"); __builtin_amdgcn_s_barrier(); asm volatile("" ::: "memory");
        const int nxt = item + G; const bool has_next = nxt < NITEMS;
        if (has_next) { t = attn_decode<MODE>(nxt); attn_load(t, QKV, kr, vr, tid);
            const size_t qr1 = (size_t)t.b * SEQ + (size_t)(128 * t.n + 16 * w + fr) * t.rr + t.c;
#pragma unroll
            for (int ks = 0; ks < 4; ++ks) qn[ks] = *(const bf16x8*)(QKV + qr1 * QKVW + t.head * 128 + 32 * ks + 8 * fq); }
        f32x4 s[9];
#pragma unroll
        for (int tt = 0; tt < 9; ++tt) { s[tt] = (f32x4){0.f, 0.f, 0.f, 0.f};
#pragma unroll
            for (int ks = 0; ks < 4; ++ks) { const bf16x8 a = *(const LAS bf16x8*)(Ks + (16 * (w + tt) + fr) * LK + 32 * ks + 8 * fq); s[tt] = __builtin_amdgcn_mfma_f32_16x16x32_bf16(a, qf[ks], s[tt], 0, 0, 0); } }
        float mx = -INFINITY;
#pragma unroll
        for (int tt = 0; tt < 9; ++tt)
#pragma unroll
            for (int r = 0; r < 4; ++r) { const int kj = 16 * (w + tt) + 4 * fq + r; const bool ok = (kj >= qi) && (kj <= qi + 128) && (n_cur > 0 || kj >= 128); s[tt][r] = ok ? s[tt][r] : -INFINITY; mx = fmaxf(mx, s[tt][r]); }
        mx = fmaxf(mx, __shfl_xor(mx, 16)); mx = fmaxf(mx, __shfl_xor(mx, 32));
        float den = 0.f;
#pragma unroll
        for (int tt = 0; tt < 9; ++tt)
#pragma unroll
            for (int r = 0; r < 4; ++r) { const float pv = __builtin_amdgcn_exp2f((s[tt][r] - mx) * 1.4426950408889634f); s[tt][r] = pv; den += pv; }
        den += __shfl_xor(den, 16); den += __shfl_xor(den, 32);
        bf16x8 P[5];
#pragma unroll
        for (int pp = 0; pp < 5; ++pp) { u32x4 pw; pw.x = cvt_pk_bf16(s[2 * pp][0], s[2 * pp][1]); pw.y = cvt_pk_bf16(s[2 * pp][2], s[2 * pp][3]);
            if (pp < 4) { pw.z = cvt_pk_bf16(s[2 * pp + 1][0], s[2 * pp + 1][1]); pw.w = cvt_pk_bf16(s[2 * pp + 1][2], s[2 * pp + 1][3]); } else { pw.z = 0u; pw.w = 0u; }
            P[pp] = __builtin_bit_cast(bf16x8, pw); }
        const float rden = 1.f / den;
        u32x2 ob0[8], ob1[8]; float wm0 = 0.f, wm1 = 0.f, wm2 = 1.f;
        if (MODE) {
#pragma unroll
            for (int te = 0; te < 8; ++te) { ob0[te] = *(const u32x2*)(OB0 + qrow * DM + head * 128 + 16 * te + 4 * fq); ob1[te] = *(const u32x2*)(OB1 + qrow * DM + head * 128 + 16 * te + 4 * fq); }
            const float l0 = LSE[qrow * 16 + head], l1 = LSE[(size_t)M_TOK * 16 + qrow * 16 + head], l2 = mx + __logf(den);
            const float lm = fmaxf(l0, fmaxf(l1, l2)); wm0 = __expf(l0 - lm); wm1 = __expf(l1 - lm); wm2 = __expf(l2 - lm); const float inv = 1.f / (wm0 + wm1 + wm2); wm0 *= inv; wm1 *= inv; wm2 *= inv;
        }
        const LAS bf16_t* vbase = Vs + (16 * w + 4 * fq + (fr >> 2)) * LV + 4 * (fr & 3);
#pragma unroll
        for (int te = 0; te < 8; ++te) { f32x4 o = {0.f, 0.f, 0.f, 0.f};
#pragma unroll
            for (int pp = 0; pp < 5; ++pp) {
                const u32x2 lo = lds_tr16(vbase + (32 * pp) * LV + 16 * te), hi = lds_tr16(vbase + (32 * pp + 16) * LV + 16 * te);
                const u32x4 aw = {lo.x, lo.y, hi.x, hi.y};
                o = __builtin_amdgcn_mfma_f32_16x16x32_bf16(__builtin_bit_cast(bf16x8, aw), P[pp], o, 0, 0, 0); }
            o = o * rden;
            if (MODE) { o[0] = wm2 * o[0] + wm0 * bflo(ob0[te].x) + wm1 * bflo(ob1[te].x); o[1] = wm2 * o[1] + wm0 * bfhi(ob0[te].x) + wm1 * bfhi(ob1[te].x);
                        o[2] = wm2 * o[2] + wm0 * bflo(ob0[te].y) + wm1 * bflo(ob1[te].y); o[3] = wm2 * o[3] + wm0 * bfhi(ob0[te].y) + wm1 * bfhi(ob1[te].y); }
            u32x2 ow; ow.x = cvt_pk_bf16(o[0], o[1]); ow.y = cvt_pk_bf16(o[2], o[3]);
            *(u32x2*)(OB + qrow * DM + head * 128 + 16 * te + 4 * fq) = ow; }
        if (!MODE && fq == 0) LSE[(size_t)br * M_TOK * 16 + qrow * 16 + head] = mx + __logf(den);
        asm volatile("s_waitcnt lgkmcnt(0)" ::: "memory"); __builtin_amdgcn_s_barrier(); asm volatile("" ::: "memory");
        if (!has_next) break;
        item = nxt;
    }
}

struct Args {
    const float* x; const float* p; const int* positions; const float* attn_norm_w; const float* ffn_norm_w; const float* ple_norm_w; const float* final_norm_w;
    const float* ab_w_in; const float* ab_gate_up; const float* ab_gate_b; const float* ab_ret_norm_w; const float* ab_gla_norm_w; const float* ab_w_out;
    const float* c_w_qkv; const float* c_w_out; const float* ffn_w_gate; const float* ffn_w_up; const float* ffn_w_down; const float* ple_w_proj; const float* ple_w_gate;
    float* out; unsigned char* ws; int st_lo, st_hi;
};
__device__ __forceinline__ float wave_sum(float v) {
#pragma unroll
    for (int o = 1; o < 64; o <<= 1) v += __shfl_xor(v, o);
    return v;
}
enum { K_NONE = 0, K_PROLOGUE, K_GPROJ, K_GSWI, K_GRES, K_MIXER, K_NORMPASS, K_CONV, K_ATTN, K_MERGE, K_FINAL };
constexpr int N_STEPS = 19;
#ifndef DBG_HI
#define DBG_HI N_STEPS
#endif

#define WSP(type, off) ((type*)(ws + (off)))
#ifdef DUP_SYNC
#define DUP_SYNC_STMT xcd_barrier(xbar);
#else
#define DUP_SYNC_STMT
#endif
#define IN(k) (st_lo <= (k) && (k) < st_hi)
#define SYNC_AFTER(k) do { if (IN(k) && IN((k) + 1)) { xcd_barrier(xbar); DUP_SYNC_STMT } } while (0)
#define RUN_GEMM(EPI, NN, e) do { pg8::StaticOrder S_; S_.init(M_TOK, (NN), (int)gridDim.x, (int)blockIdx.x); pg8::gemm_phase<EPI, pg8::StaticOrder, true, true>(lds, g, S_, e); } while (0)

#define XB_TMO      128
#define XB_XCNT(j)  (256  + 64 * (j))
#define XB_XSUB(j)  (1280 + 64 * (j))
#define XB_XGEN(j)  (2304 + 64 * (j))
#define XB_TOP      3328
#define XB_TOPGEN   3392
#define XCD_BAR_WORDS 3456
#define XB_SPIN_CAP (1u << 18)

__device__ __forceinline__ unsigned xb_ld(unsigned* p)              { return __hip_atomic_load(p, __ATOMIC_RELAXED, __HIP_MEMORY_SCOPE_AGENT); }
__device__ __forceinline__ unsigned xb_add(unsigned* p, unsigned v) { return __hip_atomic_fetch_add(p, v, __ATOMIC_RELAXED, __HIP_MEMORY_SCOPE_AGENT); }
__device__ __forceinline__ unsigned xb_xcc_id() { return (unsigned)__builtin_amdgcn_s_getreg((3 << 11) | 20) & 0xFu; }
#define XB_SPIN(cond, bar) do { unsigned _sp = 0; while (cond) { __builtin_amdgcn_s_sleep(1); \
    if ((++_sp & 255u) == 0u) { if (xb_ld(&(bar)[XB_TMO])) break; if (_sp > XB_SPIN_CAP) { atomicAdd(&(bar)[XB_TMO], 1u); break; } } } } while (0)

struct XcdBarrier {
    unsigned* bar; unsigned x;
    volatile LAS unsigned* st;
};

__device__ __forceinline__ XcdBarrier xcd_barrier_post(unsigned* bar, volatile LAS unsigned* st) {
    XcdBarrier b; b.bar = bar; b.x = xb_xcc_id(); b.st = st;
    if (threadIdx.x == 0) (void)xb_add(&bar[XB_XCNT(b.x)], 1u);
    return b;
}
__device__ __forceinline__ void xcd_barrier_complete(unsigned* bar, unsigned x, unsigned& nloc, unsigned& nx) {
    const unsigned G = gridDim.x * gridDim.y * gridDim.z;
    unsigned sum, cnt, mine, sp = 0u;
    for (;;) {
        sum = 0u; cnt = 0u; mine = 0u;
#pragma unroll
        for (unsigned j = 0; j < 16; ++j) { const unsigned c = xb_ld(&bar[XB_XCNT(j)]); sum += c; cnt += (c > 0u) ? 1u : 0u; mine = (j == x) ? c : mine; }
        if (sum == G) break;
        __builtin_amdgcn_s_sleep(1);
        if ((++sp & 255u) == 0u) { if (xb_ld(&bar[XB_TMO])) break; if (sp > XB_SPIN_CAP) { atomicAdd(&bar[XB_TMO], 1u); break; } }
    }
    nloc = mine > 0u ? mine : 1u; nx = cnt > 0u ? cnt : 1u;
}

__device__ __forceinline__ void xcd_barrier(const XcdBarrier& b) {
    asm volatile("s_waitcnt vmcnt(0)" ::: "memory");
    __syncthreads();
    if (threadIdx.x == 0) {
        unsigned* bar = b.bar;
        __builtin_amdgcn_s_waitcnt(0);
        unsigned nloc = b.st[0], nx = b.st[1];
        if (nloc == 0u) { xcd_barrier_complete(bar, b.x, nloc, nx); b.st[0] = nloc; b.st[1] = nx; }
        const unsigned old = xb_add(&bar[XB_XSUB(b.x)], 1u);
        const unsigned gen = old / nloc;
        if (old + 1u == (gen + 1u) * nloc) {
            __builtin_amdgcn_fence(__ATOMIC_RELEASE, "agent");
            asm volatile("s_waitcnt vmcnt(0)" ::: "memory");
            const unsigned og = xb_add(&bar[XB_TOP], 1u);
            const unsigned tg = og / nx;
            if (og + 1u == (tg + 1u) * nx) xb_add(&bar[XB_TOPGEN], 1u);
            else XB_SPIN(xb_ld(&bar[XB_TOPGEN]) == tg, bar);
            xb_add(&bar[XB_XGEN(b.x)], 1u);
            __builtin_amdgcn_fence(__ATOMIC_ACQUIRE, "agent");
            asm volatile("s_waitcnt vmcnt(0)" ::: "memory");
        } else {
            XB_SPIN(xb_ld(&bar[XB_XGEN(b.x)]) == gen, bar);
            __builtin_amdgcn_fence(__ATOMIC_ACQUIRE, "agent");
            asm volatile("s_waitcnt vmcnt(0)" ::: "memory");
        }
    }
    __syncthreads();
}

constexpr size_t WS_WPP1 = 66 * MiB;
constexpr size_t WS_BAR = 512 * 1024;
constexpr int LDS_BARST = LDS_BYTES - 16;
__device__ __forceinline__ void conv_jobs(ldsp lds, const Args& a, int L, int lo, int hi, int wgrank, int nwg) {
    unsigned char* ws = a.ws;
    const int tid = threadIdx.x, lane = tid & 63, wave = __builtin_amdgcn_readfirstlane(tid >> 6), gw = wgrank * 8 + wave, ngw = nwg * 8;
    LAS unsigned* scr = (LAS unsigned*)(lds + wave * (64 * 33 * 4));
    int base = 0;
    for (int j = lo; j < hi; ++j) {
        const float* W = nullptr; int K = DM, N = DM, mode = 0; bf16_t* WT = nullptr; const float* ksc = nullptr;
        switch (j) {
            case 0: if (L == 0) { W = a.ab_w_in; N = INW; } else { W = a.c_w_qkv; N = QKVW; } WT = WSP(bf16_t, WS_WIN); ksc = a.attn_norm_w + L * DM; break;
            case 1: W = (L == 0) ? a.ab_w_out : a.c_w_out; WT = WSP(bf16_t, WS_WOUT); break;
            case 2: W = a.ffn_w_gate + (size_t)L * DM * FFH; N = FFH; WT = WSP(bf16_t, WS_WGU); ksc = a.ffn_norm_w + L * DM; mode = 1; break;
            case 3: W = a.ffn_w_up + (size_t)L * DM * FFH; N = FFH; WT = WSP(bf16_t, WS_WGU); ksc = a.ffn_norm_w + L * DM; mode = 2; break;
            case 4: W = a.ffn_w_down + (size_t)L * DM * FFH; K = FFH; WT = WSP(bf16_t, WS_WD); break;
            case 5: W = a.ple_w_gate + (size_t)L * DM * DM; WT = WSP(bf16_t, WS_WPG); ksc = a.ple_norm_w + L * DM; break;
            default: W = a.ple_w_proj + (size_t)L * 256 * DM; K = 256; WT = (L == 1) ? WSP(bf16_t, WS_WPP1) : WSP(bf16_t, WS_WPP); break;
        }
        const int nit = ((N + 63) >> 6) * (K >> 6);
        const int first = ((gw - base) % ngw + ngw) % ngw;
        conv_weight(scr, W, K, N, WT, ksc, mode, first, ngw, lane);
        base += nit;
    }
}

__global__ void __launch_bounds__(512, 2) fwd_megakernel(Args a) {
    extern __shared__ __attribute__((aligned(16))) unsigned char lds_raw[];
    cg::grid_group grid = cg::this_grid();
    ldsp lds = (ldsp)lds_raw;
    unsigned char* ws = a.ws;
    const int st_lo = a.st_lo, st_hi = a.st_hi;
    float* const SSX = WSP(float, WS_SS);
    if (threadIdx.x < 2) ((volatile LAS unsigned*)(lds + LDS_BARST))[threadIdx.x] = 0u;
    __syncthreads();
    if (st_lo > 4096) grid.sync();
    const XcdBarrier xbar = xcd_barrier_post((unsigned*)(ws + WS_BAR), (volatile LAS unsigned*)(lds + LDS_BARST));

    if (IN(0)) {
        const int tid = threadIdx.x, G = gridDim.x, bid = blockIdx.x;
        const float* xin = a.x; const float* pin = a.p; const int* pos = a.positions;
        bf16_t* XB0 = WSP(bf16_t, WS_XB0); bf16_t* PB = WSP(bf16_t, WS_PB); float* ROPE = WSP(float, WS_ROPE);
        const int lane = tid & 63, gw = bid * 8 + (tid >> 6), ngw = G * 8, gt = bid * 512 + tid, ngt = G * 512;
        for (int row = gw; row < M_TOK; row += ngw) { const float* xr = xin + (size_t)row * DM; float ssq = 0.f;
#pragma unroll
            for (int j = 0; j < 8; ++j) { const f32x4 v = *(const f32x4*)(xr + (lane + 64 * j) * 4); ssq += (v[0] * v[0] + v[1] * v[1]) + (v[2] * v[2] + v[3] * v[3]);
                u32x2 w; w.x = cvt_pk_bf16(v[0], v[1]); w.y = cvt_pk_bf16(v[2], v[3]); *(u32x2*)(XB0 + (size_t)row * DM + (lane + 64 * j) * 4) = w; }
            ssq = wave_sum(ssq); if (lane == 0) SSX[row] = ssq; }
        for (int t = gt; t < 2 * M_TOK * 256 / 8; t += ngt) { const f32x4 v0 = *(const f32x4*)(pin + (size_t)t * 8), v1 = *(const f32x4*)(pin + (size_t)t * 8 + 4);
            u32x4 w; w.x = cvt_pk_bf16(v0[0], v0[1]); w.y = cvt_pk_bf16(v0[2], v0[3]); w.z = cvt_pk_bf16(v1[0], v1[1]); w.w = cvt_pk_bf16(v1[2], v1[3]); *(u32x4*)(PB + (size_t)t * 8) = w; }
        for (int t = gt; t < M_TOK * 128; t += ngt) { const int row = t >> 7, i = t & 127;
            const float invf = 1.0f / exp2f(13.287712379549449f * ((float)i * (1.0f / 127.0f)));
            const float ang = (float)pos[row] * invf;
            double rev = (double)ang * 0.15915494309189535; rev -= floor(rev); const float rv = (float)rev;
            f32x2v cs; cs.x = __builtin_amdgcn_cosf(rv); cs.y = __builtin_amdgcn_sinf(rv); *(f32x2v*)(ROPE + (size_t)t * 2) = cs; }
        for (int t = gt; t < 6 * M_TOK; t += ngt) SSX[M_TOK + t] = 0.f;
        conv_jobs(lds, a, 0, 0, 7, (int)blockIdx.x, (int)gridDim.x);
        conv_jobs(lds, a, 1, 6, 7, (int)blockIdx.x, (int)gridDim.x);
#ifdef DUP_CONV
        conv_jobs(lds, a, 0, 0, 7, (int)blockIdx.x, (int)gridDim.x);
#endif
    }
    SYNC_AFTER(0);
    if (IN(1)) { pg8::Gemm g{WSP(bf16_t, WS_XB0), WSP(bf16_t, WS_WIN), M_TOK, INW_PAD, DM}; EpiProj e{0, WSP(bf16_t, WS_Z), ZW, WSP(float, WS_GLR), SSX, WSP(const f32x4, WS_ROPE)}; RUN_GEMM(EpiProj, INW_PAD, e); }
    if (IN(1)) { const int G1 = gridDim.x, nlong = ((M_TOK / 256) * (INW_PAD / 256)) % G1;
        const bool part = (nlong > 0 && 2 * nlong < G1); const int prank = part ? (int)blockIdx.x - nlong : (int)blockIdx.x, pnum = part ? G1 - nlong : G1;
        if (prank >= 0) { pg8::Gemm g{WSP(bf16_t, WS_PB), WSP(bf16_t, WS_WPP), M_TOK, DM, 256}; EpiProj e{2, (bf16_t*)a.out + (size_t)M_TOK * DM, DM, nullptr, nullptr, nullptr};
            pg8::StaticOrder S_; S_.init(M_TOK, DM, pnum, prank); pg8::gemm_phase<EpiProj, pg8::StaticOrder, true, true>(lds, g, S_, e); } }
    SYNC_AFTER(1);
    if (IN(2)) {
#ifndef NO_MIXER
        const int tid = threadIdx.x;
        const int G_ = gridDim.x;
        {
#ifndef NO_RET
#ifdef DUP_RET
        for (int rep_ = 0; rep_ < 2; ++rep_)
#endif
        for (int u = blockIdx.x; u < 128; u += G_) { mixer_unit<256, false>(lds, u >> 4, (u >> 2) & 3, u & 3, WSP(bf16_t, WS_Z), WSP(float, WS_GLR), a.ab_gate_up, a.ab_gate_b, WSP(bf16_t, WS_O), tid); __syncthreads(); }
#endif
#ifndef NO_GLA
#ifdef DUP_GLA
        for (int rep_ = 0; rep_ < 2; ++rep_)
#endif
        for (int v = (blockIdx.x + G_ - (128 % G_)) % G_; v < 128; v += G_) { mixer_unit<128, true>(lds, v >> 4, (v >> 2) & 3, v & 3, WSP(bf16_t, WS_Z), WSP(float, WS_GLR), a.ab_gate_up, a.ab_gate_b, WSP(bf16_t, WS_O), tid); __syncthreads(); }
#endif
        }
#endif
        {   const int G2 = gridDim.x; const bool split = (G2 == 256);
            const int prank = split ? ((int)blockIdx.x < 128 ? (int)blockIdx.x : -1) : (int)blockIdx.x, pnum = split ? 128 : G2;
            if (prank >= 0) { conv_jobs(lds, a, 1, 0, 1, prank, pnum); __syncthreads(); }
            pg8::Gemm g{WSP(bf16_t, WS_PB) + (size_t)M_TOK * 256, WSP(bf16_t, WS_WPP1), M_TOK, DM, 256}; EpiProj e{2, (bf16_t*)a.out, DM, nullptr, nullptr, nullptr};
            RUN_GEMM(EpiProj, DM, e);
        }
    }
    SYNC_AFTER(2);
    if (IN(3)) {
        bf16_t* OBUF = WSP(bf16_t, WS_O); const bf16_t* ZB = WSP(bf16_t, WS_Z);
        const int tid = threadIdx.x, lane = tid & 63, gw = blockIdx.x * 8 + (tid >> 6), ngw = gridDim.x * 8;
        const float* rnw = a.ab_ret_norm_w; const float* gnw = a.ab_gla_norm_w;
        for (int row = gw; row < M_TOK; row += ngw) {
            bf16_t* op = OBUF + (size_t)row * DM + lane * 4; const bf16_t* zp = ZB + (size_t)row * ZW + lane * 4;
            u32x2 rw[8], gwd[8]; f32x4 nw[8];
#pragma unroll
            for (int hd = 0; hd < 8; ++hd) { rw[hd] = *(const u32x2*)(op + hd * 256); gwd[hd] = *(const u32x2*)(zp + (hd < 4 ? 3072 + hd * 256 : 6144 + (hd - 4) * 256));
                nw[hd] = *(const f32x4*)((hd < 4 ? rnw + hd * 256 : gnw + (hd - 4) * 256) + lane * 4); }
#pragma unroll
            for (int hd = 0; hd < 8; ++hd) {
                const float r0 = bflo(rw[hd].x), r1 = bfhi(rw[hd].x), r2 = bflo(rw[hd].y), r3 = bfhi(rw[hd].y);
                const float ssq = wave_sum((r0 * r0 + r1 * r1) + (r2 * r2 + r3 * r3));
                const float rs = rstd_of(ssq, 1.f / 256.f);
                u32x2 ow; ow.x = cvt_pk_bf16(r0 * rs * nw[hd][0] * silu_f(bflo(gwd[hd].x)), r1 * rs * nw[hd][1] * silu_f(bfhi(gwd[hd].x)));
                ow.y = cvt_pk_bf16(r2 * rs * nw[hd][2] * silu_f(bflo(gwd[hd].y)), r3 * rs * nw[hd][3] * silu_f(bfhi(gwd[hd].y)));
                *(u32x2*)(op + hd * 256) = ow; } }
    }
    SYNC_AFTER(3);
    if (IN(4)) { pg8::Gemm g{WSP(bf16_t, WS_O), WSP(bf16_t, WS_WOUT), M_TOK, DM, DM}; EpiRes e{0, WSP(bf16_t, WS_XB0), WSP(bf16_t, WS_XB1), SSX + 1 * M_TOK, nullptr, nullptr}; RUN_GEMM(EpiRes, DM, e); }
#ifdef DUP_RES
    if (IN(4)) { pg8::Gemm g{WSP(bf16_t, WS_O), WSP(bf16_t, WS_WOUT), M_TOK, DM, DM}; EpiRes e{0, WSP(bf16_t, WS_XB0), WSP(bf16_t, WS_Z + 128 * MiB), WSP(float, WS_GLR), nullptr, nullptr}; RUN_GEMM(EpiRes, DM, e); }
#endif
    SYNC_AFTER(4);
#ifdef DUP_SWI
    if (IN(6)) { pg8::Gemm g{WSP(bf16_t, WS_XB1), WSP(bf16_t, WS_WGU), M_TOK, 2 * FFH, DM}; EpiSwiglu e{WSP(bf16_t, WS_Z), SSX + 1 * M_TOK}; RUN_GEMM(EpiSwiglu, 2 * FFH, e); }
#endif
    if (IN(6)) { pg8::Gemm g{WSP(bf16_t, WS_XB1), WSP(bf16_t, WS_WGU), M_TOK, 2 * FFH, DM}; EpiSwiglu e{WSP(bf16_t, WS_Z), SSX + 1 * M_TOK}; RUN_GEMM(EpiSwiglu, 2 * FFH, e); }
    SYNC_AFTER(6);
    if (IN(7)) { pg8::Gemm g{WSP(bf16_t, WS_Z), WSP(bf16_t, WS_WD), M_TOK, DM, FFH}; EpiRes e{0, WSP(bf16_t, WS_XB1), WSP(bf16_t, WS_XB0), SSX + 2 * M_TOK, nullptr, nullptr}; RUN_GEMM(EpiRes, DM, e); }
    SYNC_AFTER(7);
    if (IN(8)) { pg8::Gemm g{WSP(bf16_t, WS_XB0), WSP(bf16_t, WS_WPG), M_TOK, DM, DM}; EpiRes e{1, WSP(bf16_t, WS_XB0), WSP(bf16_t, WS_XB1), SSX + 3 * M_TOK, SSX + 2 * M_TOK, (const bf16_t*)a.out + (size_t)M_TOK * DM}; RUN_GEMM(EpiRes, DM, e); }
    SYNC_AFTER(8);
    if (IN(9) && (((int)blockIdx.x >> 3) & 1)) { conv_jobs(lds, a, 1, 1, 6, (int)blockIdx.x, (int)gridDim.x); __syncthreads(); }
    if (IN(9)) { pg8::Gemm g{WSP(bf16_t, WS_XB1), WSP(bf16_t, WS_WIN), M_TOK, QKVW, DM}; EpiProj e{1, WSP(bf16_t, WS_Z), QKVW, nullptr, SSX + 3 * M_TOK, nullptr}; RUN_GEMM(EpiProj, QKVW, e); }
    if (IN(9) && !(((int)blockIdx.x >> 3) & 1)) conv_jobs(lds, a, 1, 1, 6, (int)blockIdx.x, (int)gridDim.x);
    SYNC_AFTER(10);
    if (IN(11)) {
#ifndef NO_ATTN
        const int tid = threadIdx.x;
        attn_phase<0>(lds, WSP(bf16_t, WS_Z), WSP(bf16_t, WS_XB0), (bf16_t*)a.out + (size_t)M_TOK * DM, WSP(bf16_t, WS_O), WSP(float, WS_LSE), tid);
#endif
    }
    SYNC_AFTER(11);
    if (IN(12)) {
#ifndef NO_ATTN
        const int tid = threadIdx.x;
        attn_phase<1>(lds, WSP(bf16_t, WS_Z), WSP(bf16_t, WS_XB0), (bf16_t*)a.out + (size_t)M_TOK * DM, WSP(bf16_t, WS_O), WSP(float, WS_LSE), tid);
#endif
    }
    SYNC_AFTER(12);
    if (IN(13)) { pg8::Gemm g{WSP(bf16_t, WS_O), WSP(bf16_t, WS_WOUT), M_TOK, DM, DM}; EpiRes e{0, WSP(bf16_t, WS_XB1), WSP(bf16_t, WS_XB0), SSX + 4 * M_TOK, nullptr, nullptr}; RUN_GEMM(EpiRes, DM, e); }
    SYNC_AFTER(13);
    if (IN(15)) { pg8::Gemm g{WSP(bf16_t, WS_XB0), WSP(bf16_t, WS_WGU), M_TOK, 2 * FFH, DM}; EpiSwiglu e{WSP(bf16_t, WS_Z), SSX + 4 * M_TOK}; RUN_GEMM(EpiSwiglu, 2 * FFH, e); }
    SYNC_AFTER(15);
    if (IN(16)) { pg8::Gemm g{WSP(bf16_t, WS_Z), WSP(bf16_t, WS_WD), M_TOK, DM, FFH}; EpiRes e{0, WSP(bf16_t, WS_XB0), WSP(bf16_t, WS_XB1), SSX + 5 * M_TOK, nullptr, nullptr}; RUN_GEMM(EpiRes, DM, e); }
    SYNC_AFTER(16);
    if (IN(17)) { pg8::Gemm g{WSP(bf16_t, WS_XB1), WSP(bf16_t, WS_WPG), M_TOK, DM, DM}; EpiRes e{1, WSP(bf16_t, WS_XB1), WSP(bf16_t, WS_XB0), SSX + 6 * M_TOK, SSX + 5 * M_TOK, (const bf16_t*)a.out}; RUN_GEMM(EpiRes, DM, e); }
    SYNC_AFTER(17);
#ifdef DBG_DUMP
    { asm volatile("s_waitcnt vmcnt(0)" ::: "memory"); __syncthreads(); grid.sync();
      const bf16_t* src = (DBG_DUMP >= 4) ? WSP(bf16_t, WS_O) : WSP(bf16_t, WS_Z) + (DBG_DUMP - 1) * 2048; const int ld = (DBG_DUMP >= 4) ? 2048 : ZW;
      const int gt = blockIdx.x * 512 + threadIdx.x, ngt = gridDim.x * 512;
      for (int t = gt; t < M_TOK * 2048; t += ngt) { const int row = t >> 11, col = t & 2047; a.out[t] = bf2f(src[(size_t)row * ld + (DBG_DUMP == 5 ? (col & 1023) : DBG_DUMP == 6 ? 1024 + (col & 1023) : col)]); } }
#endif
    if (IN(18)) {
        float* outp = a.out; const float* fnw = a.final_norm_w; const bf16_t* xres = WSP(bf16_t, WS_XB0);
        const int tid = threadIdx.x, lane = tid & 63, gw = blockIdx.x * 8 + (tid >> 6), ngw = gridDim.x * 8;
        for (int row = gw; row < M_TOK; row += ngw) { u32x4 xw[4]; float ssq = 0.f; float v[4][8];
#pragma unroll
            for (int j = 0; j < 4; ++j) xw[j] = *(const u32x4*)(xres + (size_t)row * DM + (lane + 64 * j) * 8);
#pragma unroll
            for (int j = 0; j < 4; ++j) { v[j][0] = bflo(xw[j].x); v[j][1] = bfhi(xw[j].x); v[j][2] = bflo(xw[j].y); v[j][3] = bfhi(xw[j].y); v[j][4] = bflo(xw[j].z); v[j][5] = bfhi(xw[j].z); v[j][6] = bflo(xw[j].w); v[j][7] = bfhi(xw[j].w);
#pragma unroll
                for (int q = 0; q < 8; ++q) ssq += v[j][q] * v[j][q]; }
            const float rs = rstd_of(wave_sum(ssq), 1.f / 2048.f);
#pragma unroll
            for (int j = 0; j < 4; ++j) { const f32x4 n0 = *(const f32x4*)(fnw + (lane + 64 * j) * 8), n1 = *(const f32x4*)(fnw + (lane + 64 * j) * 8 + 4);
                f32x4 o0 = {v[j][0] * rs * n0[0], v[j][1] * rs * n0[1], v[j][2] * rs * n0[2], v[j][3] * rs * n0[3]}, o1 = {v[j][4] * rs * n1[0], v[j][5] * rs * n1[1], v[j][6] * rs * n1[2], v[j][7] * rs * n1[3]};
                *(f32x4*)(outp + (size_t)row * DM + (lane + 64 * j) * 8) = o0; *(f32x4*)(outp + (size_t)row * DM + (lane + 64 * j) * 8 + 4) = o1; } }
    }
}

extern "C" void kernel_launch(void* const* d_in, const int* in_sizes, int n_in, void* d_out, int out_size, void* d_ws, size_t ws_size, hipStream_t stream) {
    static int grid = 0;
    if (grid == 0) {
        if (n_in != 20 || ws_size < WS_END) { fprintf(stderr, "kernel_launch: unexpected inputs (n_in %d, ws %zu, need %zu)\n", n_in, ws_size, (size_t)WS_END); grid = -1; return; }
        int dev = 0, cus = 0, per_cu = 0;
        (void)hipGetDevice(&dev); (void)hipDeviceGetAttribute(&cus, hipDeviceAttributeMultiprocessorCount, dev);
        if (hipFuncSetAttribute((const void*)fwd_megakernel, hipFuncAttributeMaxDynamicSharedMemorySize, LDS_BYTES) != hipSuccess) { fprintf(stderr, "kernel_launch: hipFuncSetAttribute failed\n"); grid = -1; return; }
        if (hipOccupancyMaxActiveBlocksPerMultiprocessor(&per_cu, (const void*)fwd_megakernel, 512, LDS_BYTES) != hipSuccess || per_cu < 1) { fprintf(stderr, "kernel_launch: occupancy query gave %d\n", per_cu); per_cu = 1; }
        (void)hipGetLastError();
        grid = cus * 1;
        if (grid <= 0) grid = 256;
    }
    if (grid < 0) return;
    Args a{};
    a.x = (const float*)d_in[0]; a.p = (const float*)d_in[1]; a.positions = (const int*)d_in[2]; a.attn_norm_w = (const float*)d_in[3]; a.ffn_norm_w = (const float*)d_in[4];
    a.ple_norm_w = (const float*)d_in[5]; a.final_norm_w = (const float*)d_in[6]; a.ab_w_in = (const float*)d_in[7]; a.ab_gate_up = (const float*)d_in[8]; a.ab_gate_b = (const float*)d_in[9];
    a.ab_ret_norm_w = (const float*)d_in[10]; a.ab_gla_norm_w = (const float*)d_in[11]; a.ab_w_out = (const float*)d_in[12]; a.c_w_qkv = (const float*)d_in[13]; a.c_w_out = (const float*)d_in[14];
    a.ffn_w_gate = (const float*)d_in[15]; a.ffn_w_up = (const float*)d_in[16]; a.ffn_w_down = (const float*)d_in[17]; a.ple_w_proj = (const float*)d_in[18]; a.ple_w_gate = (const float*)d_in[19];
    a.out = (float*)d_out; a.ws = (unsigned char*)d_ws; a.st_lo = 0; a.st_hi = DBG_HI;
    if (hipMemsetAsync((char*)d_ws + WS_BAR, 0, 16384, stream) != hipSuccess) { fprintf(stderr, "kernel_launch: hipMemsetAsync failed\n"); return; }
    void* args[] = {&a};
    const hipError_t e = hipLaunchCooperativeKernel((const void*)fwd_megakernel, dim3(grid), dim3(512), args, LDS_BYTES, stream);
    if (e != hipSuccess) fprintf(stderr, "kernel_launch: cooperative launch failed: %s (grid %d)\n", hipGetErrorString(e), grid);
}
```

```cpp
#include <hip/hip_runtime.h>
#include <hip/hip_cooperative_groups.h>
#include <cstdio>
#include <cstdint>
#include <cmath>
namespace cg = cooperative_groups;

namespace pg8 {
#define PG8_LAS __attribute__((address_space(3)))
typedef unsigned short bf16_t;
typedef short bf16x8 __attribute__((ext_vector_type(8)));
typedef float f32x4 __attribute__((ext_vector_type(4)));
typedef unsigned u32x4 __attribute__((ext_vector_type(4)));
constexpr int BM = 256, BK = 64, HALF = 128, HTB = HALF * BK * 2  , STAGE_BYTES = 8 * HTB, NXCD = 8, WGM = 8;

__host__ __device__ __forceinline__ int lds_byte(int r, int c) { const int st = (r >> 4) * 2 + (c >> 5), rr = r & 15, cc = c & 31, ob = rr * 64 + cc * 2; return st * 1024 + (ob ^ (((ob >> 9) & 1) << 5)); }
__host__ __device__ __forceinline__ void stage_rc(int b, int& R, int& C) { const int st = b / 1024, sb = b % 1024, swz = sb ^ (((sb >> 9) & 1) << 5); R = (st >> 1) * 16 + swz / 64; C = (st & 1) * 32 + (swz % 64) / 2; }
__host__ __device__ __forceinline__ int perm32(int rho) { const int n = rho >> 4, i = rho & 15; return 8 * (i >> 2) + 4 * n + (i & 3); }

struct Unit { int pm, pn; };
struct Gemm { const bf16_t* A; const bf16_t* Bt; int M, N, K; };

struct StaticOrder {
    int nM, nN, nwg, G, c;
    __host__ __device__ void init(int M, int N, int G_, int c_) { nM = M / BM; nN = N / BM; nwg = nM * nN; G = G_; c = c_; }
    __host__ __device__ bool next(int i, Unit& u) const {
        const long L = (long)i * G + c; if (L >= nwg) return false;
        int wgid = (int)L; { const int q = nwg / NXCD, r = nwg % NXCD, xcd = wgid % NXCD, off = wgid / NXCD; wgid = (xcd < r ? xcd * (q + 1) : r * (q + 1) + (xcd - r) * q) + off; }
        const int nig = WGM * nN, gid = wgid / nig, fm = gid * WGM, gsz = (nM - fm) < WGM ? (nM - fm) : WGM;
        u.pm = fm + ((wgid % nig) % gsz); u.pn = (wgid % nig) / gsz; return true;
    }
    __device__ __forceinline__ void a_ready(const Unit&) const {}
    __device__ __forceinline__ void done(const Unit&) const {}
};

typedef float f32x2_cv __attribute__((ext_vector_type(2))); typedef __bf16 bf16x2_cv __attribute__((ext_vector_type(2)));
__device__ __forceinline__ unsigned cvt_pk_bf16(float lo, float hi) { const f32x2_cv v = {lo, hi}; const bf16x2_cv b = __builtin_convertvector(v, bf16x2_cv); return __builtin_bit_cast(unsigned, b); }
template <class Epi, class Sched, bool ALIGN_EPI = false, bool SP2 = false>
__device__ __forceinline__ void gemm_phase(PG8_LAS unsigned char* lds, const Gemm g, const Sched& S, const Epi& E) {
    const int tid = threadIdx.x, wid = __builtin_amdgcn_readfirstlane(tid >> 6), lane = tid & 63, wr = wid >> 2, wc = wid & 3, fr = lane & 15, fq = lane >> 4;
    const int K = g.K, nt = K / BK;
    unsigned voffA[2], voffB[2];
#pragma unroll
    for (int i = 0; i < 2; ++i) { int R, C; stage_rc(tid * 16 + i * 8192, R, C); const int Rb = Epi::PERM ? ((R & ~31) + perm32(R & 31)) : R;
        voffA[i] = (unsigned)(R * K + C) * 2u; voffB[i] = (unsigned)(Rb * K + C) * 2u; }
    const size_t kstep = (size_t)(BK * 2);
    const size_t hstep = (size_t)HALF * K * 2;
    const size_t tstep = 2 * hstep;
    const unsigned ldsw = (unsigned)wid * 1024u;
    const int aoff = lds_byte(wr * 64 + fr, fq * 8), boff = lds_byte(wc * 32 + fr, fq * 8);
#define PG8_SA(b, h) (((b) * 2 + (h)) * HTB)
#define PG8_SB(b, h) ((4 + (b) * 2 + (h)) * HTB)
#define PG8_STAGE(bufoff, gbase, voff) do { _Pragma("unroll") for (int _i = 0; _i < 2; ++_i) \
        __builtin_amdgcn_global_load_lds((const unsigned*)((const char*)(gbase) + (voff)[_i]), (PG8_LAS unsigned*)(lds + (bufoff) + ldsw + _i * 8192), 16, 0, 0); } while (0)
#define PG8_LDA(dst, b, h) do { _Pragma("unroll") for (int m = 0; m < 4; ++m) _Pragma("unroll") for (int k = 0; k < 2; ++k) dst[m][k] = *(const PG8_LAS bf16x8*)(lds + PG8_SA(b, h) + aoff + m * 2048 + k * 1024); } while (0)
#define PG8_LDB(dst, b, h) do { _Pragma("unroll") for (int n = 0; n < 2; ++n) _Pragma("unroll") for (int k = 0; k < 2; ++k) dst[n][k] = *(const PG8_LAS bf16x8*)(lds + PG8_SB(b, h) + boff + n * 2048 + k * 1024); } while (0)
#define PG8_MMA(ai, bj, At, Bt) do { __builtin_amdgcn_s_setprio(1); _Pragma("unroll") for (int m = 0; m < 4; ++m) _Pragma("unroll") for (int n = 0; n < 2; ++n) _Pragma("unroll") for (int k = 0; k < 2; ++k) \
        acc[ai][bj][m][n] = __builtin_amdgcn_mfma_f32_16x16x32_bf16(Bt[n][k], At[m][k], acc[ai][bj][m][n], 0, 0, 0); __builtin_amdgcn_s_setprio(0); } while (0)
#define PG8_WAIT_V(n) asm volatile("s_waitcnt vmcnt(" #n ")" ::: "memory")
#define PG8_WAIT_L(n) asm volatile("s_waitcnt lgkmcnt(" #n ")" ::: "memory")
#define PG8_BAR __builtin_amdgcn_s_barrier()
#define PG8_SCHED __builtin_amdgcn_sched_barrier(0)
    Unit cur, nxt; int ui = 0;
    if (!S.next(0, cur)) return;
    f32x4 acc[2][2][4][2];
#pragma unroll
    for (int a = 0; a < 2; ++a)
#pragma unroll
        for (int b = 0; b < 2; ++b)
#pragma unroll
            for (int m = 0; m < 4; ++m)
#pragma unroll
                for (int n = 0; n < 2; ++n) acc[a][b][m][n] = (f32x4){0.f, 0.f, 0.f, 0.f};
    bf16x8 At[4][2], B0[2][2], B1[2][2];
    const char* cA = (const char*)g.A + (size_t)cur.pm * tstep; const char* cB = (const char*)g.Bt + (size_t)cur.pn * tstep;
    S.a_ready(cur);
    if constexpr (SP2) {
        PG8_STAGE(PG8_SB(0, 0), cB, voffB); PG8_STAGE(PG8_SB(0, 1), cB + hstep, voffB); PG8_STAGE(PG8_SA(0, 0), cA, voffA); PG8_STAGE(PG8_SA(0, 1), cA + hstep, voffA);
        if (wr == 1) PG8_BAR;
        PG8_WAIT_V(2); PG8_BAR;
        PG8_STAGE(PG8_SB(1, 0), cB + kstep, voffB); PG8_STAGE(PG8_SA(1, 0), cA + kstep, voffA); PG8_STAGE(PG8_SB(1, 1), cB + hstep + kstep, voffB);
        PG8_WAIT_V(6); PG8_BAR;
    } else {
        PG8_STAGE(PG8_SB(0, 0), cB, voffB); PG8_STAGE(PG8_SA(0, 0), cA, voffA); PG8_STAGE(PG8_SB(0, 1), cB + hstep, voffB); PG8_STAGE(PG8_SA(0, 1), cA + hstep, voffA);
        if (wr == 1) PG8_BAR;
        PG8_WAIT_V(4); PG8_BAR;
        PG8_STAGE(PG8_SB(1, 0), cB + kstep, voffB); PG8_STAGE(PG8_SA(1, 0), cA + kstep, voffA); PG8_STAGE(PG8_SB(1, 1), cB + hstep + kstep, voffB);
        PG8_WAIT_V(6); PG8_BAR;
    }
    for (;;) {
        const bool has_next = S.next(ui + 1, nxt);
        const char* nA = has_next ? (const char*)g.A + (size_t)nxt.pm * tstep : cA; const char* nB = has_next ? (const char*)g.Bt + (size_t)nxt.pn * tstep : cB;
        for (int t = 0; t < nt; t += 2) {
            const bool last = (t == nt - 2);
            const char* a1 = cA + (size_t)(t + 1) * kstep;
            const char* a2 = last ? nA : cA + (size_t)(t + 2) * kstep; const char* b2 = last ? nB : cB + (size_t)(t + 2) * kstep;
            const char* a3 = a2 + kstep; const char* b3 = b2 + kstep;
            if (last && has_next) S.a_ready(nxt);
            if constexpr (SP2) {
            PG8_LDB(B0, 0, 0); PG8_LDB(B1, 0, 1); PG8_SCHED; PG8_LDA(At, 0, 0); PG8_STAGE(PG8_SA(1, 1), a1 + hstep, voffA);
            PG8_WAIT_V(8); PG8_WAIT_L(0); PG8_BAR; PG8_MMA(0, 0, At, B0); PG8_MMA(0, 1, At, B1); PG8_BAR; PG8_SCHED;
            PG8_LDA(At, 0, 1); PG8_STAGE(PG8_SB(0, 0), b2, voffB); PG8_STAGE(PG8_SB(0, 1), b2 + hstep, voffB); PG8_STAGE(PG8_SA(0, 0), a2, voffA);
            PG8_WAIT_V(8); PG8_WAIT_L(0); PG8_BAR; PG8_MMA(1, 0, At, B0); PG8_MMA(1, 1, At, B1); PG8_BAR; PG8_SCHED;
            PG8_LDB(B0, 1, 0); PG8_LDB(B1, 1, 1); PG8_SCHED; PG8_LDA(At, 1, 0); PG8_STAGE(PG8_SA(0, 1), a2 + hstep, voffA);
            PG8_WAIT_V(8); PG8_WAIT_L(0); PG8_BAR; PG8_MMA(0, 0, At, B0); PG8_MMA(0, 1, At, B1); PG8_BAR; PG8_SCHED;
            PG8_LDA(At, 1, 1); PG8_STAGE(PG8_SB(1, 0), b3, voffB); PG8_STAGE(PG8_SB(1, 1), b3 + hstep, voffB); PG8_STAGE(PG8_SA(1, 0), a3, voffA);
            PG8_WAIT_V(8); PG8_WAIT_L(0); PG8_BAR; PG8_MMA(1, 0, At, B0); PG8_MMA(1, 1, At, B1); PG8_BAR; PG8_SCHED;
            } else {
            PG8_LDB(B0, 0, 0); PG8_SCHED; PG8_LDA(At, 0, 0); PG8_STAGE(PG8_SA(1, 1), a1 + hstep, voffA);
            PG8_WAIT_L(8); PG8_BAR; PG8_WAIT_L(0); PG8_MMA(0, 0, At, B0); PG8_BAR; PG8_SCHED;
            PG8_LDB(B1, 0, 1); PG8_STAGE(PG8_SB(0, 0), b2, voffB);
            PG8_BAR; PG8_WAIT_L(0); PG8_MMA(0, 1, At, B1); PG8_BAR;
            PG8_LDA(At, 0, 1); PG8_STAGE(PG8_SA(0, 0), a2, voffA);
            PG8_BAR; PG8_WAIT_L(0); PG8_MMA(1, 0, At, B0); PG8_BAR; PG8_SCHED;
            PG8_STAGE(PG8_SB(0, 1), b2 + hstep, voffB);
            PG8_WAIT_V(6); PG8_BAR; PG8_MMA(1, 1, At, B1); PG8_BAR;
            PG8_LDB(B0, 1, 0); PG8_SCHED; PG8_LDA(At, 1, 0); PG8_STAGE(PG8_SA(0, 1), a2 + hstep, voffA);
            PG8_WAIT_L(8); PG8_BAR; PG8_WAIT_L(0); PG8_MMA(0, 0, At, B0); PG8_BAR; PG8_SCHED;
            PG8_LDB(B1, 1, 1); PG8_STAGE(PG8_SB(1, 0), b3, voffB);
            PG8_BAR; PG8_WAIT_L(0); PG8_MMA(0, 1, At, B1); PG8_BAR;
            PG8_LDA(At, 1, 1); PG8_STAGE(PG8_SA(1, 0), a3, voffA);
            PG8_BAR; PG8_WAIT_L(0); PG8_MMA(1, 0, At, B0); PG8_BAR; PG8_SCHED;
            PG8_STAGE(PG8_SB(1, 1), b3 + hstep, voffB);
            PG8_WAIT_V(6); PG8_BAR; PG8_MMA(1, 1, At, B1); PG8_BAR;
            }
        }
        if constexpr (ALIGN_EPI) { if (wr == 0) PG8_BAR; }
        if constexpr (!Epi::AFTER_DRAIN) { E(acc, cur, wr, wc, fr, fq); S.done(cur); }
        if (!has_next) break;
#pragma unroll
        for (int a = 0; a < 2; ++a)
#pragma unroll
            for (int b = 0; b < 2; ++b)
#pragma unroll
                for (int m = 0; m < 4; ++m)
#pragma unroll
                    for (int n = 0; n < 2; ++n) acc[a][b][m][n] = (f32x4){0.f, 0.f, 0.f, 0.f};
        cur = nxt; cA = nA; cB = nB; ++ui;
        if constexpr (ALIGN_EPI) { if (wr == 1) PG8_BAR; }
    }
    PG8_WAIT_V(0);
    if constexpr (!ALIGN_EPI) { if (wr == 0) PG8_BAR; }
    PG8_BAR;
    if constexpr (Epi::AFTER_DRAIN) { E.fused(acc, cur, wr, wc, fr, fq, lds, wid, lane); S.done(cur); }
#undef PG8_SA
#undef PG8_SB
#undef PG8_STAGE
#undef PG8_LDA
#undef PG8_LDB
#undef PG8_MMA
#undef PG8_WAIT_V
#undef PG8_WAIT_L
#undef PG8_BAR
#undef PG8_SCHED
}
}

using pg8::bf16_t; using pg8::bf16x8; using pg8::f32x4; using pg8::u32x4; using pg8::Unit; using pg8::cvt_pk_bf16;
#define LAS __attribute__((address_space(3)))
typedef LAS unsigned char* ldsp;
typedef unsigned u32x2 __attribute__((ext_vector_type(2)));
typedef float f32x2v __attribute__((ext_vector_type(2)));

constexpr int M_TOK = 16384, DM = 2048, SEQ = 2048, ZW = 7168, INW = 7184, INW_PAD = 7424, FFH = 5632, QKVW = 6144;
constexpr float EPS = 1e-6f;
constexpr size_t MiB = 1u << 20;
constexpr size_t WS_SS = 0, WS_GLR = 1 * MiB, WS_LSE = 2 * MiB, WS_ROPE = 5 * MiB, WS_PB = 21 * MiB, WS_WIN = 37 * MiB, WS_WOUT = 67 * MiB, WS_WGU = 75 * MiB,
                 WS_WD = 119 * MiB, WS_WPG = 141 * MiB, WS_WPP = 149 * MiB, WS_XB0 = 150 * MiB, WS_XB1 = 214 * MiB, WS_O = 278 * MiB, WS_Z = 342 * MiB, WS_END = 566 * MiB;
constexpr int LDS_BYTES = 160 * 1024;

__device__ __forceinline__ float bf2f(unsigned h) { return __uint_as_float(h << 16); }
__device__ __forceinline__ float bflo(unsigned w) { return __uint_as_float(w << 16); }
__device__ __forceinline__ float bfhi(unsigned w) { return __uint_as_float(w & 0xffff0000u); }
__device__ __forceinline__ unsigned short f2bf(float f) { return (unsigned short)(cvt_pk_bf16(f, 0.f) & 0xffffu); }
__device__ __forceinline__ float fast_rcp(float x) { return __builtin_amdgcn_rcpf(x); }
__device__ __forceinline__ float silu_f(float x) { return x * fast_rcp(1.f + __expf(-x)); }
__device__ __forceinline__ float sigmoid_f(float x) { return fast_rcp(1.f + __expf(-x)); }
__device__ __forceinline__ float rstd_of(float ss, float inv_n) { return rsqrtf(ss * inv_n + EPS); }
#define LDS_WAIT() asm volatile("s_waitcnt lgkmcnt(0)" ::: "memory")

struct EpiProj {
    static constexpr bool PERM = true, AFTER_DRAIN = false;
    int mode; bf16_t* O; int ldo; float* GLR; const float* ss; const f32x4* rope;
    __device__ __forceinline__ void operator()(const f32x4 (&acc)[2][2][4][2], const Unit& u, int wr, int wc, int fr, int fq) const {
        const int pn = u.pn;
        float rs[2][4];
#pragma unroll
        for (int ai = 0; ai < 2; ++ai)
#pragma unroll
            for (int m = 0; m < 4; ++m) { rs[ai][m] = 1.f; if (mode != 2) rs[ai][m] = ss[u.pm * 256 + ai * 128 + wr * 64 + m * 16 + fr]; }
        const bool rot = (mode == 0) && (pn < 8);
#pragma unroll
        for (int aig = 0; aig < 4; ++aig) { const int ai = aig >> 1, mg = (aig & 1) * 2;
            f32x4 rp[4][2][2];
            if (rot) {
#pragma unroll
                for (int m = mg; m < mg + 2; ++m)
#pragma unroll
                    for (int bj = 0; bj < 2; ++bj) { const int row = u.pm * 256 + ai * 128 + wr * 64 + m * 16 + fr, col0 = pn * 256 + bj * 128 + wc * 32 + 8 * fq;
                        const f32x4* p_ = rope + (size_t)row * 64 + ((col0 & 255) >> 2); rp[m][bj][0] = p_[0]; rp[m][bj][1] = p_[1]; }
            }
#pragma unroll
            for (int m = mg; m < mg + 2; ++m) {
                const int row = u.pm * 256 + ai * 128 + wr * 64 + m * 16 + fr;
                float r_ = 1.f; if (mode != 2) r_ = rstd_of(rs[ai][m], 1.f / 2048.f);
#pragma unroll
                for (int bj = 0; bj < 2; ++bj) {
                    const int col0 = pn * 256 + bj * 128 + wc * 32 + 8 * fq;
                    f32x4 v0 = acc[ai][bj][m][0] * r_, v1 = acc[ai][bj][m][1] * r_;
                    if (mode == 0) {
                        if (pn < 8) {
                            const f32x4 c01 = rp[m][bj][0], c23 = rp[m][bj][1];
                            f32x4 r0, r1;
                            r0[0] = v0[0] * c01[0] - v0[1] * c01[1]; r0[1] = v0[0] * c01[1] + v0[1] * c01[0];
                            r0[2] = v0[2] * c01[2] - v0[3] * c01[3]; r0[3] = v0[2] * c01[3] + v0[3] * c01[2];
                            r1[0] = v1[0] * c23[0] - v1[1] * c23[1]; r1[1] = v1[0] * c23[1] + v1[1] * c23[0];
                            r1[2] = v1[2] * c23[2] - v1[3] * c23[3]; r1[3] = v1[2] * c23[3] + v1[3] * c23[2];
                            v0 = r0; v1 = r1;
                            if (pn >= 4) { v0 = v0 * 0.0625f; v1 = v1 * 0.0625f; }
                        } else if (pn == 16 || pn == 17) { v0 = v0 * 0.08838834764831845f; v1 = v1 * 0.08838834764831845f; }
                    } else if (mode == 1) { if (pn < 8) { v0 = v0 * 0.08838834764831845f; v1 = v1 * 0.08838834764831845f; } }
                    if (mode == 0 && pn == 28) {
                        if (bj == 0 && wc == 0 && fq < 2) { *(f32x4*)(GLR + (size_t)row * 16 + 8 * fq) = v0; *(f32x4*)(GLR + (size_t)row * 16 + 8 * fq + 4) = v1; }
                    } else {
                        u32x4 w; w.x = cvt_pk_bf16(v0[0], v0[1]); w.y = cvt_pk_bf16(v0[2], v0[3]); w.z = cvt_pk_bf16(v1[0], v1[1]); w.w = cvt_pk_bf16(v1[2], v1[3]);
                        *(u32x4*)(O + (size_t)row * ldo + col0) = w;
                    }
                }
            }
        }
    }
};
struct EpiSwiglu {
    static constexpr bool PERM = true, AFTER_DRAIN = false;
    bf16_t* ACT; const float* ss;
    __device__ __forceinline__ void operator()(const f32x4 (&acc)[2][2][4][2], const Unit& u, int wr, int wc, int fr, int fq) const {
        float rsv[2][4];
#pragma unroll
        for (int ai = 0; ai < 2; ++ai)
#pragma unroll
            for (int m = 0; m < 4; ++m) rsv[ai][m] = ss[u.pm * 256 + ai * 128 + wr * 64 + m * 16 + fr];
#pragma unroll
        for (int ai = 0; ai < 2; ++ai)
#pragma unroll
            for (int m = 0; m < 4; ++m) {
                const int row = u.pm * 256 + ai * 128 + wr * 64 + m * 16 + fr;
                const float rs = rstd_of(rsv[ai][m], 1.f / 2048.f);
                float o[8];
#pragma unroll
                for (int n = 0; n < 2; ++n)
#pragma unroll
                    for (int j = 0; j < 4; ++j) { const float g = acc[ai][0][m][n][j] * rs, up = acc[ai][1][m][n][j] * rs; o[n * 4 + j] = silu_f(g) * up; }
                u32x4 w; w.x = cvt_pk_bf16(o[0], o[1]); w.y = cvt_pk_bf16(o[2], o[3]); w.z = cvt_pk_bf16(o[4], o[5]); w.w = cvt_pk_bf16(o[6], o[7]);
                *(u32x4*)(ACT + (size_t)row * FFH + u.pn * 128 + wc * 32 + 8 * fq) = w;
            }
    }
};
struct EpiRes {
    static constexpr bool PERM = true, AFTER_DRAIN = false;
    int ple; const bf16_t* base; bf16_t* xb; float* ss_out; const float* ss_in; const bf16_t* pp;
    __device__ __forceinline__ void operator()(const f32x4 (&acc)[2][2][4][2], const Unit& u, int wr, int wc, int fr, int fq) const {
        float rsv[2][4];
#pragma unroll
        for (int ai = 0; ai < 2; ++ai)
#pragma unroll
            for (int m = 0; m < 4; ++m) { rsv[ai][m] = 0.f; if (ple) rsv[ai][m] = ss_in[u.pm * 256 + ai * 128 + wr * 64 + m * 16 + fr]; }
#pragma unroll
        for (int aig = 0; aig < 4; ++aig) { const int ai = aig >> 1, mg = (aig & 1) * 2;
            u32x4 bwv[4][2], pwv[4][2];
#pragma unroll
            for (int m = mg; m < mg + 2; ++m)
#pragma unroll
                for (int bj = 0; bj < 2; ++bj) { const size_t off = (size_t)(u.pm * 256 + ai * 128 + wr * 64 + m * 16 + fr) * DM + u.pn * 256 + bj * 128 + wc * 32 + 8 * fq;
                    bwv[m][bj] = *(const u32x4*)(base + off); pwv[m][bj] = (u32x4){0u, 0u, 0u, 0u}; if (ple) pwv[m][bj] = *(const u32x4*)(pp + off); }
#pragma unroll
            for (int m = mg; m < mg + 2; ++m) {
                const int row = u.pm * 256 + ai * 128 + wr * 64 + m * 16 + fr;
                float rs = 1.f; if (ple) rs = rstd_of(rsv[ai][m], 1.f / 2048.f);
                float sq = 0.f;
#pragma unroll
                for (int bj = 0; bj < 2; ++bj) {
                    const size_t off = (size_t)row * DM + u.pn * 256 + bj * 128 + wc * 32 + 8 * fq;
                    const u32x4 bw = bwv[m][bj];
                    float v[8] = {acc[ai][bj][m][0][0], acc[ai][bj][m][0][1], acc[ai][bj][m][0][2], acc[ai][bj][m][0][3], acc[ai][bj][m][1][0], acc[ai][bj][m][1][1], acc[ai][bj][m][1][2], acc[ai][bj][m][1][3]};
                    if (ple) { const u32x4 pw = pwv[m][bj];
                        const float pf[8] = {bflo(pw.x), bfhi(pw.x), bflo(pw.y), bfhi(pw.y), bflo(pw.z), bfhi(pw.z), bflo(pw.w), bfhi(pw.w)};
#pragma unroll
                        for (int j = 0; j < 8; ++j) v[j] = sigmoid_f(v[j] * rs) * pf[j]; }
                    const float bf[8] = {bflo(bw.x), bfhi(bw.x), bflo(bw.y), bfhi(bw.y), bflo(bw.z), bfhi(bw.z), bflo(bw.w), bfhi(bw.w)};
#pragma unroll
                    for (int j = 0; j < 8; ++j) { v[j] += bf[j]; sq += v[j] * v[j]; }
                    u32x4 w; w.x = cvt_pk_bf16(v[0], v[1]); w.y = cvt_pk_bf16(v[2], v[3]); w.z = cvt_pk_bf16(v[4], v[5]); w.w = cvt_pk_bf16(v[6], v[7]);
                    *(u32x4*)(xb + off) = w;
                }
                sq += __shfl_xor(sq, 16); sq += __shfl_xor(sq, 32);
                if (fq == 0) unsafeAtomicAdd(ss_out + row, sq);
            }
        }
    }
};

__device__ __forceinline__ void conv_weight(LAS unsigned* scr, const float* W, int K, int N, bf16_t* WT, const float* kscale, int mode, int first, int ngw, int lane) {
    const int nblk = (N + 63) >> 6, nitems = nblk * (K >> 6);
    const int g = lane >> 4, n4 = (lane & 15) * 4;
    for (int it = first; it < nitems; it += ngw) {
        const int kb = it / nblk, nb = it - kb * nblk, k0 = kb << 6, n0 = nb << 6;
        const bool ok = (n0 + n4) < N;
        f32x4 v[16];
#pragma unroll
        for (int i = 0; i < 16; ++i) { const int k = 8 * (i >> 1) + 2 * g + (i & 1); v[i] = (f32x4){0.f, 0.f, 0.f, 0.f}; if (ok) v[i] = *(const f32x4*)(W + (size_t)(k0 + k) * N + n0 + n4); }
        if (kscale) {
#pragma unroll
            for (int i = 0; i < 16; ++i) { const int k = 8 * (i >> 1) + 2 * g + (i & 1); v[i] = v[i] * kscale[k0 + k]; } }
#pragma unroll
        for (int m = 0; m < 8; ++m)
#pragma unroll
            for (int j = 0; j < 4; ++j) scr[(n4 + j) * 33 + 4 * m + g] = cvt_pk_bf16(v[2 * m][j], v[2 * m + 1][j]);
        LDS_WAIT();
        const int c = lane & 7;
#pragma unroll
        for (int jr = 0; jr < 8; ++jr) { const int nl = (lane >> 3) + 8 * jr, n = n0 + nl; const LAS unsigned* sp = scr + nl * 33 + 4 * c;
            const u32x4 o = {sp[0], sp[1], sp[2], sp[3]};
            int dr = n; if (mode == 1) dr = ((n >> 7) << 8) + (n & 127); else if (mode == 2) dr = ((n >> 7) << 8) + 128 + (n & 127);
            if (n < N) *(u32x4*)(WT + (size_t)dr * K + k0 + 8 * c) = o; }
        LDS_WAIT();
    }
}

typedef short v4i16_t __attribute__((ext_vector_type(4)));
__device__ __forceinline__ u32x2 lds_tr16(const LAS bf16_t* p) { return __builtin_bit_cast(u32x2, __builtin_amdgcn_ds_read_tr16_b64_v4i16((LAS v4i16_t*)p)); }
#define LBAR() do { asm volatile("s_waitcnt lgkmcnt(0)" ::: "memory"); __builtin_amdgcn_s_barrier(); asm volatile("" ::: "memory"); } while (0)
template <int DK, bool GLA>
__device__ __forceinline__ void mixer_unit(ldsp lds, int b, int h, int es, const bf16_t* Z, const float* GLR, const float* gate_up, const float* gate_b, bf16_t* Oraw, int tid) {
    constexpr int LQ = DK + 16, LT = 72, LVM = 80, NP = DK / 64, PPR = DK / 8, NT = DK / 32;
    constexpr int OFF_Q = 0, OFF_K = OFF_Q + 64 * LQ * 2, OFF_ST = OFF_K + 64 * LQ * 2, OFF_V = OFF_ST + 64 * LQ * 2, OFF_VD = OFF_V + 64 * LVM * 2, OFF_S = OFF_VD + 64 * LVM * 2, OFF_X = OFF_S + 64 * LT * 2;
    constexpr int OFF_CUM = OFF_X, OFF_SEGT = OFF_CUM + 64 * 128 * 4, OFF_EL = OFF_SEGT + 4 * 128 * 4, OFF_GLR = OFF_EL + 128 * 4, OFF_GU = OFF_GLR + 64 * 16 * 4, OFF_GB = OFF_GU + 16 * 128 * 4, OFF_ENDX = OFF_GB + 128 * 4;
    static_assert((GLA ? OFF_ENDX : OFF_X) <= LDS_BYTES, "mixer LDS");
    const int w = __builtin_amdgcn_readfirstlane(tid >> 6), lane = tid & 63, fr = lane & 15, fq = lane >> 4;
    const int qoff = GLA ? 4096 + h * 128 : h * 256, koff = GLA ? 4608 + h * 128 : 1024 + h * 256, voff = (GLA ? 5120 : 2048) + h * 256 + es * 64, ocol = (GLA ? 1024 : 0) + h * 256 + es * 64;
    const float lg = (h == 0) ? -0.0317486983145803f : (h == 1) ? -0.015748356968139168f : (h == 2) ? -0.007843177461025893f : -0.003913899321136329f;
    LAS bf16_t* Qs = (LAS bf16_t*)(lds + OFF_Q); LAS bf16_t* Ks = (LAS bf16_t*)(lds + OFF_K); LAS bf16_t* Vds = (LAS bf16_t*)(lds + OFF_VD);
    LAS bf16_t* Vs = (LAS bf16_t*)(lds + OFF_V); LAS bf16_t* Ss = (LAS bf16_t*)(lds + OFF_S); LAS bf16_t* STs = (LAS bf16_t*)(lds + OFF_ST);
    LAS float* CUM = (LAS float*)(lds + OFF_CUM); LAS float* SEGT = (LAS float*)(lds + OFF_SEGT); LAS float* EL = (LAS float*)(lds + OFF_EL);
    LAS float* GLRs = (LAS float*)(lds + OFF_GLR); LAS float* GU = (LAS float*)(lds + OFF_GU); LAS float* GB = (LAS float*)(lds + OFF_GB);
    for (int i = tid; i < 64 * LQ * 2 / 16; i += 512) ((LAS u32x4*)STs)[i] = (u32x4){0u, 0u, 0u, 0u};
    if (GLA) { for (int i = tid; i < 16 * 128; i += 512) GU[i] = gate_up[(size_t)(i >> 7) * 512 + h * 128 + (i & 127)]; if (tid < 128) GB[tid] = gate_b[h * 128 + tid]; }
    f32x4 st[NT];
#pragma unroll
    for (int t = 0; t < NT; ++t) st[t] = (f32x4){0.f, 0.f, 0.f, 0.f};
    u32x4 rq[NP], rk[NP], rv;
    const int vrow = tid >> 3, vpc = tid & 7;
    {   const size_t tb = (size_t)b * SEQ;
#pragma unroll
        for (int i = 0; i < NP; ++i) { const int p = tid + 512 * i, row = p / PPR, pc = p % PPR; rq[i] = *(const u32x4*)(Z + (tb + row) * ZW + qoff + pc * 8); rk[i] = *(const u32x4*)(Z + (tb + row) * ZW + koff + pc * 8); }
        rv = *(const u32x4*)(Z + (tb + vrow) * ZW + voff + vpc * 8); }
    const int te = w & 3, ti0 = (w >> 2) * 2;
    const int tis = w >> 1, tj0 = (w & 1) * 2;
    const int tdb = (w >> 2) * NT;
    const int trq = fr >> 2, trp = fr & 3;
    float guv[16], gbv = 0.f; f32x2v rg = {0.f, 0.f};
    if (GLA) {
        rg = *(const f32x2v*)(GLR + (size_t)b * SEQ * 16 + tid * 2);
        *(LAS f32x2v*)(GLRs + tid * 2) = rg;
        LBAR();
#pragma unroll
        for (int r = 0; r < 16; ++r) guv[r] = GU[r * 128 + (tid & 127)];
        gbv = GB[tid & 127];
        {   const int d = tid & 127, seg = tid >> 7; float run = 0.f;
#pragma unroll 4
            for (int jj = 0; jj < 16; ++jj) { const int j = seg * 16 + jj; f32x2v ua2 = {gbv, 0.f};
#pragma unroll
                    for (int r = 0; r < 16; r += 2) { const f32x2v g2 = *(const LAS f32x2v*)(GLRs + j * 16 + r); ua2 += g2 * (f32x2v){guv[r], guv[r + 1]}; }
                    const float uacc = ua2.x + ua2.y;
                run += (fminf(uacc, 0.f) - __logf(1.f + __expf(-fabsf(uacc)))) * 0.0625f; CUM[j * 128 + d] = run; }
            SEGT[seg * 128 + d] = run; }
        rg = *(const f32x2v*)(GLR + ((size_t)b * SEQ + 64) * 16 + tid * 2);
        LBAR();
    } else {
#pragma unroll
        for (int r = 0; r < 16; ++r) guv[r] = 0.f; }
    for (int c = 0; c < 32; ++c) {
        const size_t tb = (size_t)b * SEQ + (size_t)c * 64;
        if (GLA) {
            if (c < 31) *(LAS f32x2v*)(GLRs + tid * 2) = rg;
            {   const int d = tid & 127, seg = tid >> 7; float off = 0.f;
                if (seg > 0) off += SEGT[d]; if (seg > 1) off += SEGT[128 + d]; if (seg > 2) off += SEGT[256 + d];
                if (seg > 0) {
#pragma unroll
                    for (int jj = 0; jj < 16; ++jj) CUM[(seg * 16 + jj) * 128 + d] += off; }
                if (seg == 3) EL[d] = __expf(CUM[63 * 128 + d]); }
            LBAR();
        }
#pragma unroll
        for (int i = 0; i < NP; ++i) { const int p = tid + 512 * i, row = p / PPR, pc = p % PPR;
            const unsigned qw[4] = {rq[i].x, rq[i].y, rq[i].z, rq[i].w}, kw[4] = {rk[i].x, rk[i].y, rk[i].z, rk[i].w};
            if (GLA) {
                unsigned qo[4], ko[4];
#pragma unroll
                for (int jj = 0; jj < 4; ++jj) { const int d = pc * 8 + 2 * jj;
                    const float c0 = CUM[row * 128 + d], c1 = CUM[row * 128 + d + 1], l0 = CUM[63 * 128 + d], l1 = CUM[63 * 128 + d + 1];
                    const float e0 = __expf(c0), e1 = __expf(c1), k0 = bflo(kw[jj]), k1 = bfhi(kw[jj]);
                    qo[jj] = cvt_pk_bf16(bflo(qw[jj]) * e0, bfhi(qw[jj]) * e1);
                    ko[jj] = cvt_pk_bf16(k0 * fast_rcp(e0), k1 * fast_rcp(e1));
                }
                *(LAS u32x4*)(Qs + row * LQ + pc * 8) = (u32x4){qo[0], qo[1], qo[2], qo[3]};
                *(LAS u32x4*)(Ks + row * LQ + pc * 8) = (u32x4){ko[0], ko[1], ko[2], ko[3]};
            } else {
                *(LAS u32x4*)(Qs + row * LQ + pc * 8) = rq[i];
                *(LAS u32x4*)(Ks + row * LQ + pc * 8) = rk[i];
            } }
        *(LAS u32x4*)(Vs + vrow * LVM + vpc * 8) = rv;
        if (!GLA) {
            const float kd = __expf((float)(63 - vrow) * lg);
            *(LAS u32x4*)(Vds + vrow * LVM + vpc * 8) = (u32x4){cvt_pk_bf16(bflo(rv.x) * kd, bfhi(rv.x) * kd), cvt_pk_bf16(bflo(rv.y) * kd, bfhi(rv.y) * kd), cvt_pk_bf16(bflo(rv.z) * kd, bfhi(rv.z) * kd), cvt_pk_bf16(bflo(rv.w) * kd, bfhi(rv.w) * kd)}; }
        LBAR();
        if (c < 31) { const size_t tn = tb + 64;
#pragma unroll
            for (int i = 0; i < NP; ++i) { const int p = tid + 512 * i, row = p / PPR, pc = p % PPR; rq[i] = *(const u32x4*)(Z + (tn + row) * ZW + qoff + pc * 8); rk[i] = *(const u32x4*)(Z + (tn + row) * ZW + koff + pc * 8); }
            rv = *(const u32x4*)(Z + (tn + vrow) * ZW + voff + vpc * 8);
        }
        if (GLA && c < 30) rg = *(const f32x2v*)(GLR + (tb + 128) * 16 + tid * 2);
        f32x4 o2a = {0.f, 0.f, 0.f, 0.f}, o2b = {0.f, 0.f, 0.f, 0.f};
        {   f32x4 s0 = {0.f, 0.f, 0.f, 0.f}, s1 = {0.f, 0.f, 0.f, 0.f};
#pragma unroll
            for (int ks = 0; ks < NT; ++ks) {
                const bf16x8 a = *(const LAS bf16x8*)(Qs + (16 * tis + fr) * LQ + 32 * ks + 8 * fq);
                const bf16x8 b0 = *(const LAS bf16x8*)(Ks + (16 * tj0 + fr) * LQ + 32 * ks + 8 * fq), b1 = *(const LAS bf16x8*)(Ks + (16 * tj0 + 16 + fr) * LQ + 32 * ks + 8 * fq);
                s0 = __builtin_amdgcn_mfma_f32_16x16x32_bf16(a, b0, s0, 0, 0, 0); s1 = __builtin_amdgcn_mfma_f32_16x16x32_bf16(a, b1, s1, 0, 0, 0);
                const bf16x8 sa = *(const LAS bf16x8*)(STs + (16 * te + fr) * LQ + 32 * ks + 8 * fq);
                const bf16x8 q0 = *(const LAS bf16x8*)(Qs + (16 * ti0 + fr) * LQ + 32 * ks + 8 * fq), q1 = *(const LAS bf16x8*)(Qs + (16 * ti0 + 16 + fr) * LQ + 32 * ks + 8 * fq);
                o2a = __builtin_amdgcn_mfma_f32_16x16x32_bf16(sa, q0, o2a, 0, 0, 0); o2b = __builtin_amdgcn_mfma_f32_16x16x32_bf16(sa, q1, o2b, 0, 0, 0);
            }
#pragma unroll
            for (int r = 0; r < 4; ++r) { const int i = 16 * tis + 4 * fq + r, j = 16 * tj0 + fr;
                float m0, m1;
                if (GLA) { m0 = (i >= j) ? 1.f : 0.f; m1 = (i >= j + 16) ? 1.f : 0.f; }
                else { m0 = (i >= j) ? __expf((float)(i - j) * lg) : 0.f; m1 = (i >= j + 16) ? __expf((float)(i - j - 16) * lg) : 0.f; }
                Ss[i * LT + j] = f2bf(m0 != 0.f ? s0[r] * m0 : 0.f); Ss[i * LT + j + 16] = f2bf(m1 != 0.f ? s1[r] * m1 : 0.f); }
        }
        LBAR();
        if (GLA && c < 31) {
            {   const int d = tid & 127, seg = tid >> 7; float run = 0.f;
#pragma unroll 4
                for (int jj = 0; jj < 16; ++jj) { const int j = seg * 16 + jj; f32x2v ua2 = {gbv, 0.f};
#pragma unroll
                    for (int r = 0; r < 16; r += 2) { const f32x2v g2 = *(const LAS f32x2v*)(GLRs + j * 16 + r); ua2 += g2 * (f32x2v){guv[r], guv[r + 1]}; }
                    const float uacc = ua2.x + ua2.y;
                    run += (fminf(uacc, 0.f) - __logf(1.f + __expf(-fabsf(uacc)))) * 0.0625f; CUM[j * 128 + d] = run; }
                SEGT[seg * 128 + d] = run; }
        }
        {   f32x4 o1a = {0.f, 0.f, 0.f, 0.f}, o1b = {0.f, 0.f, 0.f, 0.f};
            bf16x8 vf[2], vdf[2];
#pragma unroll
            for (int ks = 0; ks < 2; ++ks) {
                const LAS bf16_t* vp = Vs + (32 * ks + 8 * fq + trq) * LVM + 16 * te + 4 * trp;
                const u32x2 vlo = lds_tr16(vp), vhi = lds_tr16(vp + 4 * LVM);
                vf[ks] = __builtin_bit_cast(bf16x8, (u32x4){vlo.x, vlo.y, vhi.x, vhi.y});
                if (!GLA) { const LAS bf16_t* dp = Vds + (32 * ks + 8 * fq + trq) * LVM + 16 * te + 4 * trp; const u32x2 dlo = lds_tr16(dp), dhi = lds_tr16(dp + 4 * LVM); vdf[ks] = __builtin_bit_cast(bf16x8, (u32x4){dlo.x, dlo.y, dhi.x, dhi.y}); } else vdf[ks] = vf[ks];
                const bf16x8 b0 = *(const LAS bf16x8*)(Ss + (16 * ti0 + fr) * LT + 32 * ks + 8 * fq), b1 = *(const LAS bf16x8*)(Ss + (16 * ti0 + 16 + fr) * LT + 32 * ks + 8 * fq);
                o1a = __builtin_amdgcn_mfma_f32_16x16x32_bf16(vf[ks], b0, o1a, 0, 0, 0); o1b = __builtin_amdgcn_mfma_f32_16x16x32_bf16(vf[ks], b1, o1b, 0, 0, 0);
            }
            const int ia = 16 * ti0 + fr, ib = ia + 16;
            const float qa = GLA ? 1.f : __expf((float)(ia + 1) * lg), qb = GLA ? 1.f : __expf((float)(ib + 1) * lg);
            const f32x4 oa = o1a + o2a * qa, ob = o1b + o2b * qb;
            u32x2 wa, wb; wa.x = cvt_pk_bf16(oa[0], oa[1]); wa.y = cvt_pk_bf16(oa[2], oa[3]); wb.x = cvt_pk_bf16(ob[0], ob[1]); wb.y = cvt_pk_bf16(ob[2], ob[3]);
            *(u32x2*)(Oraw + (tb + ia) * DM + ocol + 16 * te + 4 * fq) = wa;
            *(u32x2*)(Oraw + (tb + ib) * DM + ocol + 16 * te + 4 * fq) = wb;
            const float cd = __expf(64.f * lg);
#pragma unroll
            for (int t = 0; t < NT; ++t) { const int td = tdb + t;
                if (!GLA) st[t] = st[t] * cd;
#pragma unroll
                for (int ks = 0; ks < 2; ++ks) { const LAS bf16_t* kp = Ks + (32 * ks + 8 * fq + trq) * LQ + 16 * td + 4 * trp;
                    const u32x2 klo = lds_tr16(kp), khi = lds_tr16(kp + 4 * LQ);
                    st[t] = __builtin_amdgcn_mfma_f32_16x16x32_bf16(__builtin_bit_cast(bf16x8, (u32x4){klo.x, klo.y, khi.x, khi.y}), vdf[ks], st[t], 0, 0, 0); }
                if (GLA) { const f32x4 el = *(const LAS f32x4*)(EL + 16 * td + 4 * fq); st[t] = st[t] * el; }
                u32x2 sw; sw.x = cvt_pk_bf16(st[t][0], st[t][1]); sw.y = cvt_pk_bf16(st[t][2], st[t][3]);
                *(LAS u32x2*)(STs + (16 * te + fr) * LQ + 16 * td + 4 * fq) = sw; }
        }
        LBAR();
    }
}

struct AttnItem { int b, head, br, rr, c, n; };
__device__ __forceinline__ AttnItem attn_decode(int item) { AttnItem t; const int bh = item / 48, rem = item - bh * 48, cn = rem & 15; t.br = rem >> 4; const int sh = 2 * t.br; t.rr = 1 << sh; t.c = cn & (t.rr - 1); t.n = cn >> sh; t.b = bh >> 4; t.head = bh & 15; return t; }
constexpr int ATT_LK = 136, ATT_LV = 144, ATT_OFF_VS = 256 * ATT_LK * 2;
static_assert(ATT_OFF_VS + 272 * ATT_LV * 2 <= LDS_BYTES, "attention LDS");
__device__ __forceinline__ void attn_load(const AttnItem& t, const bf16_t* QKV, u32x4 (&kr)[8], u32x4 (&vr)[8], int tid) {
    const size_t rowb = (size_t)t.b * SEQ;
#pragma unroll
    for (int i = 0; i < 8; ++i) { const int p = tid + 512 * i, kj = p >> 4, pc = p & 15, us = 128 * (t.n - 1) + kj;
        kr[i] = (u32x4){0u, 0u, 0u, 0u}; vr[i] = (u32x4){0u, 0u, 0u, 0u};
        if (us >= 0) { const size_t row = rowb + (size_t)us * t.rr + t.c; kr[i] = *(const u32x4*)(QKV + row * QKVW + 2048 + t.head * 128 + pc * 8); vr[i] = *(const u32x4*)(QKV + row * QKVW + 4096 + t.head * 128 + pc * 8); } }
}
__device__ __forceinline__ void attn_phase(ldsp lds, const bf16_t* QKV, bf16_t* OB0, bf16_t* OB1, bf16_t* OB2, float* LSE, int tid) {
    constexpr int LK = ATT_LK, LV = ATT_LV;
    const int w = __builtin_amdgcn_readfirstlane(tid >> 6), lane = tid & 63, fr = lane & 15, fq = lane >> 4;
    LAS bf16_t* Ks = (LAS bf16_t*)lds; LAS bf16_t* Vs = (LAS bf16_t*)(lds + ATT_OFF_VS);
    const int G = gridDim.x;
    int item = blockIdx.x;
    if (item >= 6144) return;
    if (tid < 256) *(LAS u32x4*)(Vs + (256 + (tid >> 4)) * LV + (tid & 15) * 8) = (u32x4){0u, 0u, 0u, 0u};
    u32x4 kr[8], vr[8];
    AttnItem t = attn_decode(item);
    attn_load(t, QKV, kr, vr, tid);
    bf16x8 qn[4];
    {   const size_t qr0 = (size_t)t.b * SEQ + (size_t)(128 * t.n + 16 * w + fr) * t.rr + t.c;
#pragma unroll
        for (int ks = 0; ks < 4; ++ks) qn[ks] = *(const bf16x8*)(QKV + qr0 * QKVW + t.head * 128 + 32 * ks + 8 * fq); }
    for (;;) {
        bf16_t* OB = t.br == 0 ? OB0 : (t.br == 1 ? OB1 : OB2);
        const int qi = 16 * w + fr;
        const size_t qrow = (size_t)t.b * SEQ + (size_t)(128 * t.n + qi) * t.rr + t.c;
        const int n_cur = t.n, head = t.head, br = t.br;
        bf16x8 qf[4];
#pragma unroll
        for (int ks = 0; ks < 4; ++ks) qf[ks] = qn[ks];
#pragma unroll
        for (int i = 0; i < 8; ++i) { const int p = tid + 512 * i, kj = p >> 4, pc = p & 15; *(LAS u32x4*)(Ks + kj * LK + pc * 8) = kr[i]; *(LAS u32x4*)(Vs + kj * LV + pc * 8) = vr[i]; }
        asm volatile("s_waitcnt lgkmcnt(0)" ::: "memory"); __builtin_amdgcn_s_barrier(); asm volatile("" ::: "memory");
        const int nxt = item + G; const bool has_next = nxt < 6144;
        if (has_next) { t = attn_decode(nxt); attn_load(t, QKV, kr, vr, tid);
            const size_t qr1 = (size_t)t.b * SEQ + (size_t)(128 * t.n + 16 * w + fr) * t.rr + t.c;
#pragma unroll
            for (int ks = 0; ks < 4; ++ks) qn[ks] = *(const bf16x8*)(QKV + qr1 * QKVW + t.head * 128 + 32 * ks + 8 * fq); }
        f32x4 s[9];
#pragma unroll
        for (int tt = 0; tt < 9; ++tt) { s[tt] = (f32x4){0.f, 0.f, 0.f, 0.f};
#pragma unroll
            for (int ks = 0; ks < 4; ++ks) { const bf16x8 a = *(const LAS bf16x8*)(Ks + (16 * (w + tt) + fr) * LK + 32 * ks + 8 * fq); s[tt] = __builtin_amdgcn_mfma_f32_16x16x32_bf16(a, qf[ks], s[tt], 0, 0, 0); } }
        float mx = -INFINITY;
#pragma unroll
        for (int tt = 0; tt < 9; ++tt)
#pragma unroll
            for (int r = 0; r < 4; ++r) { const int kj = 16 * (w + tt) + 4 * fq + r; const bool ok = (kj >= qi) && (kj <= qi + 128) && (n_cur > 0 || kj >= 128); s[tt][r] = ok ? s[tt][r] : -INFINITY; mx = fmaxf(mx, s[tt][r]); }
        mx = fmaxf(mx, __shfl_xor(mx, 16)); mx = fmaxf(mx, __shfl_xor(mx, 32));
        float den = 0.f;
#pragma unroll
        for (int tt = 0; tt < 9; ++tt)
#pragma unroll
            for (int r = 0; r < 4; ++r) { const float pv = __builtin_amdgcn_exp2f((s[tt][r] - mx) * 1.4426950408889634f); s[tt][r] = pv; den += pv; }
        den += __shfl_xor(den, 16); den += __shfl_xor(den, 32);
        bf16x8 P[5];
#pragma unroll
        for (int pp = 0; pp < 5; ++pp) { u32x4 pw; pw.x = cvt_pk_bf16(s[2 * pp][0], s[2 * pp][1]); pw.y = cvt_pk_bf16(s[2 * pp][2], s[2 * pp][3]);
            if (pp < 4) { pw.z = cvt_pk_bf16(s[2 * pp + 1][0], s[2 * pp + 1][1]); pw.w = cvt_pk_bf16(s[2 * pp + 1][2], s[2 * pp + 1][3]); } else { pw.z = 0u; pw.w = 0u; }
            P[pp] = __builtin_bit_cast(bf16x8, pw); }
        const float rden = 1.f / den;
        const LAS bf16_t* vbase = Vs + (16 * w + 4 * fq + (fr >> 2)) * LV + 4 * (fr & 3);
#pragma unroll
        for (int te = 0; te < 8; ++te) { f32x4 o = {0.f, 0.f, 0.f, 0.f};
#pragma unroll
            for (int pp = 0; pp < 5; ++pp) {
                const u32x2 lo = lds_tr16(vbase + (32 * pp) * LV + 16 * te), hi = lds_tr16(vbase + (32 * pp + 16) * LV + 16 * te);
                const u32x4 aw = {lo.x, lo.y, hi.x, hi.y};
                o = __builtin_amdgcn_mfma_f32_16x16x32_bf16(__builtin_bit_cast(bf16x8, aw), P[pp], o, 0, 0, 0); }
            o = o * rden; u32x2 ow; ow.x = cvt_pk_bf16(o[0], o[1]); ow.y = cvt_pk_bf16(o[2], o[3]);
            *(u32x2*)(OB + qrow * DM + head * 128 + 16 * te + 4 * fq) = ow; }
        if (fq == 0) LSE[(size_t)br * M_TOK * 16 + qrow * 16 + head] = mx + __logf(den);
        asm volatile("s_waitcnt lgkmcnt(0)" ::: "memory"); __builtin_amdgcn_s_barrier(); asm volatile("" ::: "memory");
        if (!has_next) break;
        item = nxt;
    }
}

struct Args {
    const float* x; const float* p; const int* positions; const float* attn_norm_w; const float* ffn_norm_w; const float* ple_norm_w; const float* final_norm_w;
    const float* ab_w_in; const float* ab_gate_up; const float* ab_gate_b; const float* ab_ret_norm_w; const float* ab_gla_norm_w; const float* ab_w_out;
    const float* c_w_qkv; const float* c_w_out; const float* ffn_w_gate; const float* ffn_w_up; const float* ffn_w_down; const float* ple_w_proj; const float* ple_w_gate;
    float* out; unsigned char* ws; int st_lo, st_hi;
};
__device__ __forceinline__ float wave_sum(float v) {
#pragma unroll
    for (int o = 1; o < 64; o <<= 1) v += __shfl_xor(v, o);
    return v;
}
enum { K_NONE = 0, K_PROLOGUE, K_GPROJ, K_GSWI, K_GRES, K_MIXER, K_NORMPASS, K_CONV, K_ATTN, K_MERGE, K_FINAL };
constexpr int N_STEPS = 19;
#ifndef DBG_HI
#define DBG_HI N_STEPS
#endif

#define WSP(type, off) ((type*)(ws + (off)))
#ifdef DUP_SYNC
#define DUP_SYNC_STMT xcd_barrier(xbar);
#else
#define DUP_SYNC_STMT
#endif
#define IN(k) (st_lo <= (k) && (k) < st_hi)
#define SYNC_AFTER(k) do { if (IN(k) && IN((k) + 1)) { xcd_barrier(xbar); DUP_SYNC_STMT } } while (0)
#define RUN_GEMM(EPI, NN, e) do { pg8::StaticOrder S_; S_.init(M_TOK, (NN), (int)gridDim.x, (int)blockIdx.x); pg8::gemm_phase<EPI, pg8::StaticOrder, true, true>(lds, g, S_, e); } while (0)

#define XB_TMO      128
#define XB_XCNT(j)  (256  + 64 * (j))
#define XB_XSUB(j)  (1280 + 64 * (j))
#define XB_XGEN(j)  (2304 + 64 * (j))
#define XB_TOP      3328
#define XB_TOPGEN   3392
#define XCD_BAR_WORDS 3456
#define XB_SPIN_CAP (1u << 18)

__device__ __forceinline__ unsigned xb_ld(unsigned* p)              { return __hip_atomic_load(p, __ATOMIC_RELAXED, __HIP_MEMORY_SCOPE_AGENT); }
__device__ __forceinline__ unsigned xb_add(unsigned* p, unsigned v) { return __hip_atomic_fetch_add(p, v, __ATOMIC_RELAXED, __HIP_MEMORY_SCOPE_AGENT); }
__device__ __forceinline__ unsigned xb_xcc_id() { return (unsigned)__builtin_amdgcn_s_getreg((3 << 11) | 20) & 0xFu; }
#define XB_SPIN(cond, bar) do { unsigned _sp = 0; while (cond) { __builtin_amdgcn_s_sleep(1); \
    if ((++_sp & 255u) == 0u) { if (xb_ld(&(bar)[XB_TMO])) break; if (_sp > XB_SPIN_CAP) { atomicAdd(&(bar)[XB_TMO], 1u); break; } } } } while (0)

struct XcdBarrier {
    unsigned* bar; unsigned x;
    volatile LAS unsigned* st;
};

__device__ __forceinline__ XcdBarrier xcd_barrier_post(unsigned* bar, volatile LAS unsigned* st) {
    XcdBarrier b; b.bar = bar; b.x = xb_xcc_id(); b.st = st;
    if (threadIdx.x == 0) (void)xb_add(&bar[XB_XCNT(b.x)], 1u);
    return b;
}
__device__ __forceinline__ void xcd_barrier_complete(unsigned* bar, unsigned x, unsigned& nloc, unsigned& nx) {
    const unsigned G = gridDim.x * gridDim.y * gridDim.z;
    unsigned sum, cnt, mine, sp = 0u;
    for (;;) {
        sum = 0u; cnt = 0u; mine = 0u;
#pragma unroll
        for (unsigned j = 0; j < 16; ++j) { const unsigned c = xb_ld(&bar[XB_XCNT(j)]); sum += c; cnt += (c > 0u) ? 1u : 0u; mine = (j == x) ? c : mine; }
        if (sum == G) break;
        __builtin_amdgcn_s_sleep(1);
        if ((++sp & 255u) == 0u) { if (xb_ld(&bar[XB_TMO])) break; if (sp > XB_SPIN_CAP) { atomicAdd(&bar[XB_TMO], 1u); break; } }
    }
    nloc = mine > 0u ? mine : 1u; nx = cnt > 0u ? cnt : 1u;
}

__device__ __forceinline__ void xcd_barrier(const XcdBarrier& b) {
    asm volatile("s_waitcnt vmcnt(0)" ::: "memory");
    __syncthreads();
    if (threadIdx.x == 0) {
        unsigned* bar = b.bar;
        __builtin_amdgcn_s_waitcnt(0);
        unsigned nloc = b.st[0], nx = b.st[1];
        if (nloc == 0u) { xcd_barrier_complete(bar, b.x, nloc, nx); b.st[0] = nloc; b.st[1] = nx; }
        const unsigned old = xb_add(&bar[XB_XSUB(b.x)], 1u);
        const unsigned gen = old / nloc;
        if (old + 1u == (gen + 1u) * nloc) {
            __builtin_amdgcn_fence(__ATOMIC_RELEASE, "agent");
            asm volatile("s_waitcnt vmcnt(0)" ::: "memory");
            const unsigned og = xb_add(&bar[XB_TOP], 1u);
            const unsigned tg = og / nx;
            if (og + 1u == (tg + 1u) * nx) xb_add(&bar[XB_TOPGEN], 1u);
            else XB_SPIN(xb_ld(&bar[XB_TOPGEN]) == tg, bar);
            xb_add(&bar[XB_XGEN(b.x)], 1u);
            __builtin_amdgcn_fence(__ATOMIC_ACQUIRE, "agent");
            asm volatile("s_waitcnt vmcnt(0)" ::: "memory");
        } else {
            XB_SPIN(xb_ld(&bar[XB_XGEN(b.x)]) == gen, bar);
            __builtin_amdgcn_fence(__ATOMIC_ACQUIRE, "agent");
            asm volatile("s_waitcnt vmcnt(0)" ::: "memory");
        }
    }
    __syncthreads();
}

constexpr size_t WS_WPP1 = 66 * MiB;
constexpr size_t WS_BAR = 512 * 1024;
constexpr int LDS_BARST = LDS_BYTES - 16;
__device__ __forceinline__ void conv_jobs(ldsp lds, const Args& a, int L, int lo, int hi, int wgrank, int nwg) {
    unsigned char* ws = a.ws;
    const int tid = threadIdx.x, lane = tid & 63, wave = __builtin_amdgcn_readfirstlane(tid >> 6), gw = wgrank * 8 + wave, ngw = nwg * 8;
    LAS unsigned* scr = (LAS unsigned*)(lds + wave * (64 * 33 * 4));
    int base = 0;
    for (int j = lo; j < hi; ++j) {
        const float* W = nullptr; int K = DM, N = DM, mode = 0; bf16_t* WT = nullptr; const float* ksc = nullptr;
        switch (j) {
            case 0: if (L == 0) { W = a.ab_w_in; N = INW; } else { W = a.c_w_qkv; N = QKVW; } WT = WSP(bf16_t, WS_WIN); ksc = a.attn_norm_w + L * DM; break;
            case 1: W = (L == 0) ? a.ab_w_out : a.c_w_out; WT = WSP(bf16_t, WS_WOUT); break;
            case 2: W = a.ffn_w_gate + (size_t)L * DM * FFH; N = FFH; WT = WSP(bf16_t, WS_WGU); ksc = a.ffn_norm_w + L * DM; mode = 1; break;
            case 3: W = a.ffn_w_up + (size_t)L * DM * FFH; N = FFH; WT = WSP(bf16_t, WS_WGU); ksc = a.ffn_norm_w + L * DM; mode = 2; break;
            case 4: W = a.ffn_w_down + (size_t)L * DM * FFH; K = FFH; WT = WSP(bf16_t, WS_WD); break;
            case 5: W = a.ple_w_gate + (size_t)L * DM * DM; WT = WSP(bf16_t, WS_WPG); ksc = a.ple_norm_w + L * DM; break;
            default: W = a.ple_w_proj + (size_t)L * 256 * DM; K = 256; WT = (L == 1) ? WSP(bf16_t, WS_WPP1) : WSP(bf16_t, WS_WPP); break;
        }
        const int nit = ((N + 63) >> 6) * (K >> 6);
        const int first = ((gw - base) % ngw + ngw) % ngw;
        conv_weight(scr, W, K, N, WT, ksc, mode, first, ngw, lane);
        base += nit;
    }
}

__global__ void __launch_bounds__(512, 2) fwd_megakernel(Args a) {
    extern __shared__ __attribute__((aligned(16))) unsigned char lds_raw[];
    cg::grid_group grid = cg::this_grid();
    ldsp lds = (ldsp)lds_raw;
    unsigned char* ws = a.ws;
    const int st_lo = a.st_lo, st_hi = a.st_hi;
    float* const SSX = WSP(float, WS_SS);
    if (threadIdx.x < 2) ((volatile LAS unsigned*)(lds + LDS_BARST))[threadIdx.x] = 0u;
    __syncthreads();
    if (st_lo > 4096) grid.sync();
    const XcdBarrier xbar = xcd_barrier_post((unsigned*)(ws + WS_BAR), (volatile LAS unsigned*)(lds + LDS_BARST));

    if (IN(0)) {
        const int tid = threadIdx.x, G = gridDim.x, bid = blockIdx.x;
        const float* xin = a.x; const float* pin = a.p; const int* pos = a.positions;
        bf16_t* XB0 = WSP(bf16_t, WS_XB0); bf16_t* PB = WSP(bf16_t, WS_PB); float* ROPE = WSP(float, WS_ROPE);
        const int lane = tid & 63, gw = bid * 8 + (tid >> 6), ngw = G * 8, gt = bid * 512 + tid, ngt = G * 512;
        for (int row = gw; row < M_TOK; row += ngw) { const float* xr = xin + (size_t)row * DM; float ssq = 0.f;
#pragma unroll
            for (int j = 0; j < 8; ++j) { const f32x4 v = *(const f32x4*)(xr + (lane + 64 * j) * 4); ssq += (v[0] * v[0] + v[1] * v[1]) + (v[2] * v[2] + v[3] * v[3]);
                u32x2 w; w.x = cvt_pk_bf16(v[0], v[1]); w.y = cvt_pk_bf16(v[2], v[3]); *(u32x2*)(XB0 + (size_t)row * DM + (lane + 64 * j) * 4) = w; }
            ssq = wave_sum(ssq); if (lane == 0) SSX[row] = ssq; }
        for (int t = gt; t < 2 * M_TOK * 256 / 8; t += ngt) { const f32x4 v0 = *(const f32x4*)(pin + (size_t)t * 8), v1 = *(const f32x4*)(pin + (size_t)t * 8 + 4);
            u32x4 w; w.x = cvt_pk_bf16(v0[0], v0[1]); w.y = cvt_pk_bf16(v0[2], v0[3]); w.z = cvt_pk_bf16(v1[0], v1[1]); w.w = cvt_pk_bf16(v1[2], v1[3]); *(u32x4*)(PB + (size_t)t * 8) = w; }
        for (int t = gt; t < M_TOK * 128; t += ngt) { const int row = t >> 7, i = t & 127;
            const float invf = 1.0f / exp2f(13.287712379549449f * ((float)i * (1.0f / 127.0f)));
            const float ang = (float)pos[row] * invf;
            double rev = (double)ang * 0.15915494309189535; rev -= floor(rev); const float rv = (float)rev;
            f32x2v cs; cs.x = __builtin_amdgcn_cosf(rv); cs.y = __builtin_amdgcn_sinf(rv); *(f32x2v*)(ROPE + (size_t)t * 2) = cs; }
        for (int t = gt; t < 6 * M_TOK; t += ngt) SSX[M_TOK + t] = 0.f;
        conv_jobs(lds, a, 0, 0, 7, (int)blockIdx.x, (int)gridDim.x);
        conv_jobs(lds, a, 1, 6, 7, (int)blockIdx.x, (int)gridDim.x);
#ifdef DUP_CONV
        conv_jobs(lds, a, 0, 0, 7, (int)blockIdx.x, (int)gridDim.x);
#endif
    }
    SYNC_AFTER(0);
    if (IN(1)) { pg8::Gemm g{WSP(bf16_t, WS_XB0), WSP(bf16_t, WS_WIN), M_TOK, INW_PAD, DM}; EpiProj e{0, WSP(bf16_t, WS_Z), ZW, WSP(float, WS_GLR), SSX, WSP(const f32x4, WS_ROPE)}; RUN_GEMM(EpiProj, INW_PAD, e); }
    if (IN(1)) { const int G1 = gridDim.x, nlong = ((M_TOK / 256) * (INW_PAD / 256)) % G1;
        const bool part = (nlong > 0 && 2 * nlong < G1); const int prank = part ? (int)blockIdx.x - nlong : (int)blockIdx.x, pnum = part ? G1 - nlong : G1;
        if (prank >= 0) { pg8::Gemm g{WSP(bf16_t, WS_PB), WSP(bf16_t, WS_WPP), M_TOK, DM, 256}; EpiProj e{2, (bf16_t*)a.out + (size_t)M_TOK * DM, DM, nullptr, nullptr, nullptr};
            pg8::StaticOrder S_; S_.init(M_TOK, DM, pnum, prank); pg8::gemm_phase<EpiProj, pg8::StaticOrder, true, true>(lds, g, S_, e); } }
    SYNC_AFTER(1);
    if (IN(2)) {
#ifndef NO_MIXER
        const int tid = threadIdx.x;
        const int G_ = gridDim.x;
        {
#ifndef NO_RET
#ifdef DUP_RET
        for (int rep_ = 0; rep_ < 2; ++rep_)
#endif
        for (int u = blockIdx.x; u < 128; u += G_) { mixer_unit<256, false>(lds, u >> 4, (u >> 2) & 3, u & 3, WSP(bf16_t, WS_Z), WSP(float, WS_GLR), a.ab_gate_up, a.ab_gate_b, WSP(bf16_t, WS_O), tid); __syncthreads(); }
#endif
#ifndef NO_GLA
#ifdef DUP_GLA
        for (int rep_ = 0; rep_ < 2; ++rep_)
#endif
        for (int v = (blockIdx.x + G_ - (128 % G_)) % G_; v < 128; v += G_) { mixer_unit<128, true>(lds, v >> 4, (v >> 2) & 3, v & 3, WSP(bf16_t, WS_Z), WSP(float, WS_GLR), a.ab_gate_up, a.ab_gate_b, WSP(bf16_t, WS_O), tid); __syncthreads(); }
#endif
        }
#endif
        {   const int G2 = gridDim.x; const bool split = (G2 == 256);
            const int prank = split ? ((int)blockIdx.x < 128 ? (int)blockIdx.x : -1) : (int)blockIdx.x, pnum = split ? 128 : G2;
            if (prank >= 0) { conv_jobs(lds, a, 1, 0, 1, prank, pnum); __syncthreads(); }
            pg8::Gemm g{WSP(bf16_t, WS_PB) + (size_t)M_TOK * 256, WSP(bf16_t, WS_WPP1), M_TOK, DM, 256}; EpiProj e{2, (bf16_t*)a.out, DM, nullptr, nullptr, nullptr};
            RUN_GEMM(EpiProj, DM, e);
        }
    }
    SYNC_AFTER(2);
    if (IN(3)) {
        bf16_t* OBUF = WSP(bf16_t, WS_O); const bf16_t* ZB = WSP(bf16_t, WS_Z);
        const int tid = threadIdx.x, lane = tid & 63, gw = blockIdx.x * 8 + (tid >> 6), ngw = gridDim.x * 8;
        const float* rnw = a.ab_ret_norm_w; const float* gnw = a.ab_gla_norm_w;
        for (int row = gw; row < M_TOK; row += ngw) {
            bf16_t* op = OBUF + (size_t)row * DM + lane * 4; const bf16_t* zp = ZB + (size_t)row * ZW + lane * 4;
            u32x2 rw[8], gwd[8]; f32x4 nw[8];
#pragma unroll
            for (int hd = 0; hd < 8; ++hd) { rw[hd] = *(const u32x2*)(op + hd * 256); gwd[hd] = *(const u32x2*)(zp + (hd < 4 ? 3072 + hd * 256 : 6144 + (hd - 4) * 256));
                nw[hd] = *(const f32x4*)((hd < 4 ? rnw + hd * 256 : gnw + (hd - 4) * 256) + lane * 4); }
#pragma unroll
            for (int hd = 0; hd < 8; ++hd) {
                const float r0 = bflo(rw[hd].x), r1 = bfhi(rw[hd].x), r2 = bflo(rw[hd].y), r3 = bfhi(rw[hd].y);
                const float ssq = wave_sum((r0 * r0 + r1 * r1) + (r2 * r2 + r3 * r3));
                const float rs = rstd_of(ssq, 1.f / 256.f);
                u32x2 ow; ow.x = cvt_pk_bf16(r0 * rs * nw[hd][0] * silu_f(bflo(gwd[hd].x)), r1 * rs * nw[hd][1] * silu_f(bfhi(gwd[hd].x)));
                ow.y = cvt_pk_bf16(r2 * rs * nw[hd][2] * silu_f(bflo(gwd[hd].y)), r3 * rs * nw[hd][3] * silu_f(bfhi(gwd[hd].y)));
                *(u32x2*)(op + hd * 256) = ow; } }
    }
    SYNC_AFTER(3);
    if (IN(4)) { pg8::Gemm g{WSP(bf16_t, WS_O), WSP(bf16_t, WS_WOUT), M_TOK, DM, DM}; EpiRes e{0, WSP(bf16_t, WS_XB0), WSP(bf16_t, WS_XB1), SSX + 1 * M_TOK, nullptr, nullptr}; RUN_GEMM(EpiRes, DM, e); }
#ifdef DUP_RES
    if (IN(4)) { pg8::Gemm g{WSP(bf16_t, WS_O), WSP(bf16_t, WS_WOUT), M_TOK, DM, DM}; EpiRes e{0, WSP(bf16_t, WS_XB0), WSP(bf16_t, WS_Z + 128 * MiB), WSP(float, WS_GLR), nullptr, nullptr}; RUN_GEMM(EpiRes, DM, e); }
#endif
    SYNC_AFTER(4);
#ifdef DUP_SWI
    if (IN(6)) { pg8::Gemm g{WSP(bf16_t, WS_XB1), WSP(bf16_t, WS_WGU), M_TOK, 2 * FFH, DM}; EpiSwiglu e{WSP(bf16_t, WS_Z), SSX + 1 * M_TOK}; RUN_GEMM(EpiSwiglu, 2 * FFH, e); }
#endif
    if (IN(6)) { pg8::Gemm g{WSP(bf16_t, WS_XB1), WSP(bf16_t, WS_WGU), M_TOK, 2 * FFH, DM}; EpiSwiglu e{WSP(bf16_t, WS_Z), SSX + 1 * M_TOK}; RUN_GEMM(EpiSwiglu, 2 * FFH, e); }
    SYNC_AFTER(6);
    if (IN(7)) { pg8::Gemm g{WSP(bf16_t, WS_Z), WSP(bf16_t, WS_WD), M_TOK, DM, FFH}; EpiRes e{0, WSP(bf16_t, WS_XB1), WSP(bf16_t, WS_XB0), SSX + 2 * M_TOK, nullptr, nullptr}; RUN_GEMM(EpiRes, DM, e); }
    SYNC_AFTER(7);
    if (IN(8)) { pg8::Gemm g{WSP(bf16_t, WS_XB0), WSP(bf16_t, WS_WPG), M_TOK, DM, DM}; EpiRes e{1, WSP(bf16_t, WS_XB0), WSP(bf16_t, WS_XB1), SSX + 3 * M_TOK, SSX + 2 * M_TOK, (const bf16_t*)a.out + (size_t)M_TOK * DM}; RUN_GEMM(EpiRes, DM, e); }
    SYNC_AFTER(8);
    if (IN(9) && (((int)blockIdx.x >> 3) & 1)) { conv_jobs(lds, a, 1, 1, 6, (int)blockIdx.x, (int)gridDim.x); __syncthreads(); }
    if (IN(9)) { pg8::Gemm g{WSP(bf16_t, WS_XB1), WSP(bf16_t, WS_WIN), M_TOK, QKVW, DM}; EpiProj e{1, WSP(bf16_t, WS_Z), QKVW, nullptr, SSX + 3 * M_TOK, nullptr}; RUN_GEMM(EpiProj, QKVW, e); }
    if (IN(9) && !(((int)blockIdx.x >> 3) & 1)) conv_jobs(lds, a, 1, 1, 6, (int)blockIdx.x, (int)gridDim.x);
    SYNC_AFTER(10);
    if (IN(11)) {
#ifndef NO_ATTN
        const int tid = threadIdx.x;
        attn_phase(lds, WSP(bf16_t, WS_Z), WSP(bf16_t, WS_XB0), (bf16_t*)a.out + (size_t)M_TOK * DM, WSP(bf16_t, WS_O), WSP(float, WS_LSE), tid);
#ifdef DUP_ATTN
        attn_phase(lds, WSP(bf16_t, WS_Z), WSP(bf16_t, WS_XB0), (bf16_t*)a.out + (size_t)M_TOK * DM, WSP(bf16_t, WS_O), WSP(float, WS_LSE), tid);
#endif
#endif
    }
    SYNC_AFTER(11);
    if (IN(12)) {
        const float* LSE = WSP(float, WS_LSE); const bf16_t* XB0 = WSP(bf16_t, WS_XB0); const bf16_t* XB1 = (const bf16_t*)a.out + (size_t)M_TOK * DM; bf16_t* OBUF = WSP(bf16_t, WS_O);
        const int tid = threadIdx.x, lane = tid & 63, gw = blockIdx.x * 8 + (tid >> 6), ngw = gridDim.x * 8;
        for (int row = gw; row < M_TOK; row += ngw) {
            u32x4 a0[4], a1[4], a2[4]; float l0[4], l1[4], l2[4];
#pragma unroll
            for (int i = 0; i < 4; ++i) { const int ch = lane + 64 * i, head = ch >> 4; const size_t off = (size_t)row * DM + ch * 8;
                a0[i] = *(const u32x4*)(XB0 + off); a1[i] = *(const u32x4*)(XB1 + off); a2[i] = *(const u32x4*)(OBUF + off);
                l0[i] = LSE[(size_t)row * 16 + head]; l1[i] = LSE[(size_t)M_TOK * 16 + (size_t)row * 16 + head]; l2[i] = LSE[(size_t)2 * M_TOK * 16 + (size_t)row * 16 + head]; }
#pragma unroll
            for (int i = 0; i < 4; ++i) { const int ch = lane + 64 * i; const size_t off = (size_t)row * DM + ch * 8;
                const float mx = fmaxf(l0[i], fmaxf(l1[i], l2[i])); float w0 = __expf(l0[i] - mx), w1 = __expf(l1[i] - mx), w2 = __expf(l2[i] - mx); const float inv = 1.f / (w0 + w1 + w2); w0 *= inv; w1 *= inv; w2 *= inv;
                u32x4 o;
                o.x = cvt_pk_bf16(w0 * bflo(a0[i].x) + w1 * bflo(a1[i].x) + w2 * bflo(a2[i].x), w0 * bfhi(a0[i].x) + w1 * bfhi(a1[i].x) + w2 * bfhi(a2[i].x));
                o.y = cvt_pk_bf16(w0 * bflo(a0[i].y) + w1 * bflo(a1[i].y) + w2 * bflo(a2[i].y), w0 * bfhi(a0[i].y) + w1 * bfhi(a1[i].y) + w2 * bfhi(a2[i].y));
                o.z = cvt_pk_bf16(w0 * bflo(a0[i].z) + w1 * bflo(a1[i].z) + w2 * bflo(a2[i].z), w0 * bfhi(a0[i].z) + w1 * bfhi(a1[i].z) + w2 * bfhi(a2[i].z));
                o.w = cvt_pk_bf16(w0 * bflo(a0[i].w) + w1 * bflo(a1[i].w) + w2 * bflo(a2[i].w), w0 * bfhi(a0[i].w) + w1 * bfhi(a1[i].w) + w2 * bfhi(a2[i].w));
                *(u32x4*)(OBUF + off) = o; } }
    }
    SYNC_AFTER(12);
    if (IN(13)) { pg8::Gemm g{WSP(bf16_t, WS_O), WSP(bf16_t, WS_WOUT), M_TOK, DM, DM}; EpiRes e{0, WSP(bf16_t, WS_XB1), WSP(bf16_t, WS_XB0), SSX + 4 * M_TOK, nullptr, nullptr}; RUN_GEMM(EpiRes, DM, e); }
    SYNC_AFTER(13);
    if (IN(15)) { pg8::Gemm g{WSP(bf16_t, WS_XB0), WSP(bf16_t, WS_WGU), M_TOK, 2 * FFH, DM}; EpiSwiglu e{WSP(bf16_t, WS_Z), SSX + 4 * M_TOK}; RUN_GEMM(EpiSwiglu, 2 * FFH, e); }
    SYNC_AFTER(15);
    if (IN(16)) { pg8::Gemm g{WSP(bf16_t, WS_Z), WSP(bf16_t, WS_WD), M_TOK, DM, FFH}; EpiRes e{0, WSP(bf16_t, WS_XB0), WSP(bf16_t, WS_XB1), SSX + 5 * M_TOK, nullptr, nullptr}; RUN_GEMM(EpiRes, DM, e); }
    SYNC_AFTER(16);
    if (IN(17)) { pg8::Gemm g{WSP(bf16_t, WS_XB1), WSP(bf16_t, WS_WPG), M_TOK, DM, DM}; EpiRes e{1, WSP(bf16_t, WS_XB1), WSP(bf16_t, WS_XB0), SSX + 6 * M_TOK, SSX + 5 * M_TOK, (const bf16_t*)a.out}; RUN_GEMM(EpiRes, DM, e); }
    SYNC_AFTER(17);
#ifdef DBG_DUMP
    { asm volatile("s_waitcnt vmcnt(0)" ::: "memory"); __syncthreads(); grid.sync();
      const bf16_t* src = (DBG_DUMP >= 4) ? WSP(bf16_t, WS_O) : WSP(bf16_t, WS_Z) + (DBG_DUMP - 1) * 2048; const int ld = (DBG_DUMP >= 4) ? 2048 : ZW;
      const int gt = blockIdx.x * 512 + threadIdx.x, ngt = gridDim.x * 512;
      for (int t = gt; t < M_TOK * 2048; t += ngt) { const int row = t >> 11, col = t & 2047; a.out[t] = bf2f(src[(size_t)row * ld + (DBG_DUMP == 5 ? (col & 1023) : DBG_DUMP == 6 ? 1024 + (col & 1023) : col)]); } }
#endif
    if (IN(18)) {
        float* outp = a.out; const float* fnw = a.final_norm_w; const bf16_t* xres = WSP(bf16_t, WS_XB0);
        const int tid = threadIdx.x, lane = tid & 63, gw = blockIdx.x * 8 + (tid >> 6), ngw = gridDim.x * 8;
        for (int row = gw; row < M_TOK; row += ngw) { u32x4 xw[4]; float ssq = 0.f; float v[4][8];
#pragma unroll
            for (int j = 0; j < 4; ++j) xw[j] = *(const u32x4*)(xres + (size_t)row * DM + (lane + 64 * j) * 8);
#pragma unroll
            for (int j = 0; j < 4; ++j) { v[j][0] = bflo(xw[j].x); v[j][1] = bfhi(xw[j].x); v[j][2] = bflo(xw[j].y); v[j][3] = bfhi(xw[j].y); v[j][4] = bflo(xw[j].z); v[j][5] = bfhi(xw[j].z); v[j][6] = bflo(xw[j].w); v[j][7] = bfhi(xw[j].w);
#pragma unroll
                for (int q = 0; q < 8; ++q) ssq += v[j][q] * v[j][q]; }
            const float rs = rstd_of(wave_sum(ssq), 1.f / 2048.f);
#pragma unroll
            for (int j = 0; j < 4; ++j) { const f32x4 n0 = *(const f32x4*)(fnw + (lane + 64 * j) * 8), n1 = *(const f32x4*)(fnw + (lane + 64 * j) * 8 + 4);
                f32x4 o0 = {v[j][0] * rs * n0[0], v[j][1] * rs * n0[1], v[j][2] * rs * n0[2], v[j][3] * rs * n0[3]}, o1 = {v[j][4] * rs * n1[0], v[j][5] * rs * n1[1], v[j][6] * rs * n1[2], v[j][7] * rs * n1[3]};
                *(f32x4*)(outp + (size_t)row * DM + (lane + 64 * j) * 8) = o0; *(f32x4*)(outp + (size_t)row * DM + (lane + 64 * j) * 8 + 4) = o1; } }
    }
}

extern "C" void kernel_launch(void* const* d_in, const int* in_sizes, int n_in, void* d_out, int out_size, void* d_ws, size_t ws_size, hipStream_t stream) {
    static int grid = 0;
    if (grid == 0) {
        if (n_in != 20 || ws_size < WS_END) { fprintf(stderr, "kernel_launch: unexpected inputs (n_in %d, ws %zu, need %zu)\n", n_in, ws_size, (size_t)WS_END); grid = -1; return; }
        int dev = 0, cus = 0, per_cu = 0;
        (void)hipGetDevice(&dev); (void)hipDeviceGetAttribute(&cus, hipDeviceAttributeMultiprocessorCount, dev);
        if (hipFuncSetAttribute((const void*)fwd_megakernel, hipFuncAttributeMaxDynamicSharedMemorySize, LDS_BYTES) != hipSuccess) { fprintf(stderr, "kernel_launch: hipFuncSetAttribute failed\n"); grid = -1; return; }
        if (hipOccupancyMaxActiveBlocksPerMultiprocessor(&per_cu, (const void*)fwd_megakernel, 512, LDS_BYTES) != hipSuccess || per_cu < 1) { fprintf(stderr, "kernel_launch: occupancy query gave %d\n", per_cu); per_cu = 1; }
        (void)hipGetLastError();
        grid = cus * 1;
        if (grid <= 0) grid = 256;
    }
    if (grid < 0) return;
    Args a{};
    a.x = (const float*)d_in[0]; a.p = (const float*)d_in[1]; a.positions = (const int*)d_in[2]; a.attn_norm_w = (const float*)d_in[3]; a.ffn_norm_w = (const float*)d_in[4];
    a.ple_norm_w = (const float*)d_in[5]; a.final_norm_w = (const float*)d_in[6]; a.ab_w_in = (const float*)d_in[7]; a.ab_gate_up = (const float*)d_in[8]; a.ab_gate_b = (const float*)d_in[9];
    a.ab_ret_norm_w = (const float*)d_in[10]; a.ab_gla_norm_w = (const float*)d_in[11]; a.ab_w_out = (const float*)d_in[12]; a.c_w_qkv = (const float*)d_in[13]; a.c_w_out = (const float*)d_in[14];
    a.ffn_w_gate = (const float*)d_in[15]; a.ffn_w_up = (const float*)d_in[16]; a.ffn_w_down = (const float*)d_in[17]; a.ple_w_proj = (const float*)d_in[18]; a.ple_w_gate = (const float*)d_in[19];
    a.out = (float*)d_out; a.ws = (unsigned char*)d_ws; a.st_lo = 0; a.st_hi = DBG_HI;
    if (hipMemsetAsync((char*)d_ws + WS_BAR, 0, 16384, stream) != hipSuccess) { fprintf(stderr, "kernel_launch: hipMemsetAsync failed\n"); return; }
    void* args[] = {&a};
    const hipError_t e = hipLaunchCooperativeKernel((const void*)fwd_megakernel, dim3(grid), dim3(512), args, LDS_BYTES, stream);
    if (e != hipSuccess) fprintf(stderr, "kernel_launch: cooperative launch failed: %s (grid %d)\n", hipGetErrorString(e), grid);
}
```

```cpp
#include <hip/hip_runtime.h>
#include <hip/hip_cooperative_groups.h>
#include <cstdio>
#include <cstdint>
#include <cmath>
namespace cg = cooperative_groups;

namespace pg8 {
#define PG8_LAS __attribute__((address_space(3)))
typedef unsigned short bf16_t;
typedef short bf16x8 __attribute__((ext_vector_type(8)));
typedef float f32x4 __attribute__((ext_vector_type(4)));
typedef unsigned u32x4 __attribute__((ext_vector_type(4)));
constexpr int BM = 256, BK = 64, HALF = 128, HTB = HALF * BK * 2  , STAGE_BYTES = 8 * HTB, NXCD = 8, WGM = 8;

__host__ __device__ __forceinline__ int lds_byte(int r, int c) { const int st = (r >> 4) * 2 + (c >> 5), rr = r & 15, cc = c & 31, ob = rr * 64 + cc * 2; return st * 1024 + (ob ^ (((ob >> 9) & 1) << 5)); }
__host__ __device__ __forceinline__ void stage_rc(int b, int& R, int& C) { const int st = b / 1024, sb = b % 1024, swz = sb ^ (((sb >> 9) & 1) << 5); R = (st >> 1) * 16 + swz / 64; C = (st & 1) * 32 + (swz % 64) / 2; }
__host__ __device__ __forceinline__ int perm32(int rho) { const int n = rho >> 4, i = rho & 15; return 8 * (i >> 2) + 4 * n + (i & 3); }

struct Unit { int pm, pn; };
struct Gemm { const bf16_t* A; const bf16_t* Bt; int M, N, K; };

struct StaticOrder {
    int nM, nN, nwg, G, c;
    __host__ __device__ void init(int M, int N, int G_, int c_) { nM = M / BM; nN = N / BM; nwg = nM * nN; G = G_; c = c_; }
    __host__ __device__ bool next(int i, Unit& u) const {
        const long L = (long)i * G + c; if (L >= nwg) return false;
        int wgid = (int)L; { const int q = nwg / NXCD, r = nwg % NXCD, xcd = wgid % NXCD, off = wgid / NXCD; wgid = (xcd < r ? xcd * (q + 1) : r * (q + 1) + (xcd - r) * q) + off; }
        const int nig = WGM * nN, gid = wgid / nig, fm = gid * WGM, gsz = (nM - fm) < WGM ? (nM - fm) : WGM;
        u.pm = fm + ((wgid % nig) % gsz); u.pn = (wgid % nig) / gsz; return true;
    }
    __device__ __forceinline__ void a_ready(const Unit&) const {}
    __device__ __forceinline__ void done(const Unit&) const {}
};

typedef float f32x2_cv __attribute__((ext_vector_type(2))); typedef __bf16 bf16x2_cv __attribute__((ext_vector_type(2)));
__device__ __forceinline__ unsigned cvt_pk_bf16(float lo, float hi) { const f32x2_cv v = {lo, hi}; const bf16x2_cv b = __builtin_convertvector(v, bf16x2_cv); return __builtin_bit_cast(unsigned, b); }
template <class Epi, class Sched, bool ALIGN_EPI = false, bool SP2 = false>
__device__ __forceinline__ void gemm_phase(PG8_LAS unsigned char* lds, const Gemm g, const Sched& S, const Epi& E) {
    const int tid = threadIdx.x, wid = __builtin_amdgcn_readfirstlane(tid >> 6), lane = tid & 63, wr = wid >> 2, wc = wid & 3, fr = lane & 15, fq = lane >> 4;
    const int K = g.K, nt = K / BK;
    unsigned voffA[2], voffB[2];
#pragma unroll
    for (int i = 0; i < 2; ++i) { int R, C; stage_rc(tid * 16 + i * 8192, R, C); const int Rb = Epi::PERM ? ((R & ~31) + perm32(R & 31)) : R;
        voffA[i] = (unsigned)(R * K + C) * 2u; voffB[i] = (unsigned)(Rb * K + C) * 2u; }
    const size_t kstep = (size_t)(BK * 2);
    const size_t hstep = (size_t)HALF * K * 2;
    const size_t tstep = 2 * hstep;
    const unsigned ldsw = (unsigned)wid * 1024u;
    const int aoff = lds_byte(wr * 64 + fr, fq * 8), boff = lds_byte(wc * 32 + fr, fq * 8);
#define PG8_SA(b, h) (((b) * 2 + (h)) * HTB)
#define PG8_SB(b, h) ((4 + (b) * 2 + (h)) * HTB)
#define PG8_STAGE(bufoff, gbase, voff) do { _Pragma("unroll") for (int _i = 0; _i < 2; ++_i) \
        __builtin_amdgcn_global_load_lds((const unsigned*)((const char*)(gbase) + (voff)[_i]), (PG8_LAS unsigned*)(lds + (bufoff) + ldsw + _i * 8192), 16, 0, 0); } while (0)
#define PG8_LDA(dst, b, h) do { _Pragma("unroll") for (int m = 0; m < 4; ++m) _Pragma("unroll") for (int k = 0; k < 2; ++k) dst[m][k] = *(const PG8_LAS bf16x8*)(lds + PG8_SA(b, h) + aoff + m * 2048 + k * 1024); } while (0)
#define PG8_LDB(dst, b, h) do { _Pragma("unroll") for (int n = 0; n < 2; ++n) _Pragma("unroll") for (int k = 0; k < 2; ++k) dst[n][k] = *(const PG8_LAS bf16x8*)(lds + PG8_SB(b, h) + boff + n * 2048 + k * 1024); } while (0)
#define PG8_MMA(ai, bj, At, Bt) do { __builtin_amdgcn_s_setprio(1); _Pragma("unroll") for (int m = 0; m < 4; ++m) _Pragma("unroll") for (int n = 0; n < 2; ++n) _Pragma("unroll") for (int k = 0; k < 2; ++k) \
        acc[ai][bj][m][n] = __builtin_amdgcn_mfma_f32_16x16x32_bf16(Bt[n][k], At[m][k], acc[ai][bj][m][n], 0, 0, 0); __builtin_amdgcn_s_setprio(0); } while (0)
#define PG8_WAIT_V(n) asm volatile("s_waitcnt vmcnt(" #n ")" ::: "memory")
#define PG8_WAIT_L(n) asm volatile("s_waitcnt lgkmcnt(" #n ")" ::: "memory")
#define PG8_BAR __builtin_amdgcn_s_barrier()
#define PG8_SCHED __builtin_amdgcn_sched_barrier(0)
    Unit cur, nxt; int ui = 0;
    if (!S.next(0, cur)) return;
    f32x4 acc[2][2][4][2];
#pragma unroll
    for (int a = 0; a < 2; ++a)
#pragma unroll
        for (int b = 0; b < 2; ++b)
#pragma unroll
            for (int m = 0; m < 4; ++m)
#pragma unroll
                for (int n = 0; n < 2; ++n) acc[a][b][m][n] = (f32x4){0.f, 0.f, 0.f, 0.f};
    bf16x8 At[4][2], B0[2][2], B1[2][2];
    const char* cA = (const char*)g.A + (size_t)cur.pm * tstep; const char* cB = (const char*)g.Bt + (size_t)cur.pn * tstep;
    S.a_ready(cur);
    if constexpr (SP2) {
        PG8_STAGE(PG8_SB(0, 0), cB, voffB); PG8_STAGE(PG8_SB(0, 1), cB + hstep, voffB); PG8_STAGE(PG8_SA(0, 0), cA, voffA); PG8_STAGE(PG8_SA(0, 1), cA + hstep, voffA);
        if (wr == 1) PG8_BAR;
        PG8_WAIT_V(2); PG8_BAR;
        PG8_STAGE(PG8_SB(1, 0), cB + kstep, voffB); PG8_STAGE(PG8_SA(1, 0), cA + kstep, voffA); PG8_STAGE(PG8_SB(1, 1), cB + hstep + kstep, voffB);
        PG8_WAIT_V(6); PG8_BAR;
    } else {
        PG8_STAGE(PG8_SB(0, 0), cB, voffB); PG8_STAGE(PG8_SA(0, 0), cA, voffA); PG8_STAGE(PG8_SB(0, 1), cB + hstep, voffB); PG8_STAGE(PG8_SA(0, 1), cA + hstep, voffA);
        if (wr == 1) PG8_BAR;
        PG8_WAIT_V(4); PG8_BAR;
        PG8_STAGE(PG8_SB(1, 0), cB + kstep, voffB); PG8_STAGE(PG8_SA(1, 0), cA + kstep, voffA); PG8_STAGE(PG8_SB(1, 1), cB + hstep + kstep, voffB);
        PG8_WAIT_V(6); PG8_BAR;
    }
    for (;;) {
        const bool has_next = S.next(ui + 1, nxt);
        const char* nA = has_next ? (const char*)g.A + (size_t)nxt.pm * tstep : cA; const char* nB = has_next ? (const char*)g.Bt + (size_t)nxt.pn * tstep : cB;
        for (int t = 0; t < nt; t += 2) {
            const bool last = (t == nt - 2);
            const char* a1 = cA + (size_t)(t + 1) * kstep;
            const char* a2 = last ? nA : cA + (size_t)(t + 2) * kstep; const char* b2 = last ? nB : cB + (size_t)(t + 2) * kstep;
            const char* a3 = a2 + kstep; const char* b3 = b2 + kstep;
            if (last && has_next) S.a_ready(nxt);
            if constexpr (SP2) {
            PG8_LDB(B0, 0, 0); PG8_LDB(B1, 0, 1); PG8_SCHED; PG8_LDA(At, 0, 0); PG8_STAGE(PG8_SA(1, 1), a1 + hstep, voffA);
            PG8_WAIT_V(8); PG8_WAIT_L(0); PG8_BAR; PG8_MMA(0, 0, At, B0); PG8_MMA(0, 1, At, B1); PG8_BAR; PG8_SCHED;
            PG8_LDA(At, 0, 1); PG8_STAGE(PG8_SB(0, 0), b2, voffB); PG8_STAGE(PG8_SB(0, 1), b2 + hstep, voffB); PG8_STAGE(PG8_SA(0, 0), a2, voffA);
            PG8_WAIT_V(8); PG8_WAIT_L(0); PG8_BAR; PG8_MMA(1, 0, At, B0); PG8_MMA(1, 1, At, B1); PG8_BAR; PG8_SCHED;
            PG8_LDB(B0, 1, 0); PG8_LDB(B1, 1, 1); PG8_SCHED; PG8_LDA(At, 1, 0); PG8_STAGE(PG8_SA(0, 1), a2 + hstep, voffA);
            PG8_WAIT_V(8); PG8_WAIT_L(0); PG8_BAR; PG8_MMA(0, 0, At, B0); PG8_MMA(0, 1, At, B1); PG8_BAR; PG8_SCHED;
            PG8_LDA(At, 1, 1); PG8_STAGE(PG8_SB(1, 0), b3, voffB); PG8_STAGE(PG8_SB(1, 1), b3 + hstep, voffB); PG8_STAGE(PG8_SA(1, 0), a3, voffA);
            PG8_WAIT_V(8); PG8_WAIT_L(0); PG8_BAR; PG8_MMA(1, 0, At, B0); PG8_MMA(1, 1, At, B1); PG8_BAR; PG8_SCHED;
            } else {
            PG8_LDB(B0, 0, 0); PG8_SCHED; PG8_LDA(At, 0, 0); PG8_STAGE(PG8_SA(1, 1), a1 + hstep, voffA);
            PG8_WAIT_L(8); PG8_BAR; PG8_WAIT_L(0); PG8_MMA(0, 0, At, B0); PG8_BAR; PG8_SCHED;
            PG8_LDB(B1, 0, 1); PG8_STAGE(PG8_SB(0, 0), b2, voffB);
            PG8_BAR; PG8_WAIT_L(0); PG8_MMA(0, 1, At, B1); PG8_BAR;
            PG8_LDA(At, 0, 1); PG8_STAGE(PG8_SA(0, 0), a2, voffA);
            PG8_BAR; PG8_WAIT_L(0); PG8_MMA(1, 0, At, B0); PG8_BAR; PG8_SCHED;
            PG8_STAGE(PG8_SB(0, 1), b2 + hstep, voffB);
            PG8_WAIT_V(6); PG8_BAR; PG8_MMA(1, 1, At, B1); PG8_BAR;
            PG8_LDB(B0, 1, 0); PG8_SCHED; PG8_LDA(At, 1, 0); PG8_STAGE(PG8_SA(0, 1), a2 + hstep, voffA);
            PG8_WAIT_L(8); PG8_BAR; PG8_WAIT_L(0); PG8_MMA(0, 0, At, B0); PG8_BAR; PG8_SCHED;
            PG8_LDB(B1, 1, 1); PG8_STAGE(PG8_SB(1, 0), b3, voffB);
            PG8_BAR; PG8_WAIT_L(0); PG8_MMA(0, 1, At, B1); PG8_BAR;
            PG8_LDA(At, 1, 1); PG8_STAGE(PG8_SA(1, 0), a3, voffA);
            PG8_BAR; PG8_WAIT_L(0); PG8_MMA(1, 0, At, B0); PG8_BAR; PG8_SCHED;
            PG8_STAGE(PG8_SB(1, 1), b3 + hstep, voffB);
            PG8_WAIT_V(6); PG8_BAR; PG8_MMA(1, 1, At, B1); PG8_BAR;
            }
        }
        if constexpr (ALIGN_EPI) { if (wr == 0) PG8_BAR; }
        if constexpr (!Epi::AFTER_DRAIN) { E(acc, cur, wr, wc, fr, fq); S.done(cur); }
        if (!has_next) break;
#pragma unroll
        for (int a = 0; a < 2; ++a)
#pragma unroll
            for (int b = 0; b < 2; ++b)
#pragma unroll
                for (int m = 0; m < 4; ++m)
#pragma unroll
                    for (int n = 0; n < 2; ++n) acc[a][b][m][n] = (f32x4){0.f, 0.f, 0.f, 0.f};
        cur = nxt; cA = nA; cB = nB; ++ui;
        if constexpr (ALIGN_EPI) { if (wr == 1) PG8_BAR; }
    }
    PG8_WAIT_V(0);
    if constexpr (!ALIGN_EPI) { if (wr == 0) PG8_BAR; }
    PG8_BAR;
    if constexpr (Epi::AFTER_DRAIN) { E.fused(acc, cur, wr, wc, fr, fq, lds, wid, lane); S.done(cur); }
#undef PG8_SA
#undef PG8_SB
#undef PG8_STAGE
#undef PG8_LDA
#undef PG8_LDB
#undef PG8_MMA
#undef PG8_WAIT_V
#undef PG8_WAIT_L
#undef PG8_BAR
#undef PG8_SCHED
}
}

using pg8::bf16_t; using pg8::bf16x8; using pg8::f32x4; using pg8::u32x4; using pg8::Unit; using pg8::cvt_pk_bf16;
#define LAS __attribute__((address_space(3)))
typedef LAS unsigned char* ldsp;
typedef unsigned u32x2 __attribute__((ext_vector_type(2)));
typedef float f32x2v __attribute__((ext_vector_type(2)));

constexpr int M_TOK = 16384, DM = 2048, SEQ = 2048, ZW = 7168, INW = 7184, INW_PAD = 7424, FFH = 5632, QKVW = 6144;
constexpr float EPS = 1e-6f;
constexpr size_t MiB = 1u << 20;
constexpr size_t WS_SS = 0, WS_GLR = 1 * MiB, WS_LSE = 2 * MiB, WS_ROPE = 5 * MiB, WS_PB = 21 * MiB, WS_WIN = 37 * MiB, WS_WOUT = 67 * MiB, WS_WGU = 75 * MiB,
                 WS_WD = 119 * MiB, WS_WPG = 141 * MiB, WS_WPP = 149 * MiB, WS_XB0 = 150 * MiB, WS_XB1 = 214 * MiB, WS_O = 278 * MiB, WS_Z = 342 * MiB, WS_END = 566 * MiB;
constexpr int LDS_BYTES = 160 * 1024;

__device__ __forceinline__ float bf2f(unsigned h) { return __uint_as_float(h << 16); }
__device__ __forceinline__ float bflo(unsigned w) { return __uint_as_float(w << 16); }
__device__ __forceinline__ float bfhi(unsigned w) { return __uint_as_float(w & 0xffff0000u); }
__device__ __forceinline__ unsigned short f2bf(float f) { return (unsigned short)(cvt_pk_bf16(f, 0.f) & 0xffffu); }
__device__ __forceinline__ float fast_rcp(float x) { return __builtin_amdgcn_rcpf(x); }
__device__ __forceinline__ float silu_f(float x) { return x * fast_rcp(1.f + __expf(-x)); }
__device__ __forceinline__ float sigmoid_f(float x) { return fast_rcp(1.f + __expf(-x)); }
__device__ __forceinline__ float rstd_of(float ss, float inv_n) { return rsqrtf(ss * inv_n + EPS); }
#define LDS_WAIT() asm volatile("s_waitcnt lgkmcnt(0)" ::: "memory")

struct EpiProj {
    static constexpr bool PERM = true, AFTER_DRAIN = false;
    int mode; bf16_t* O; int ldo; float* GLR; const float* ss; const f32x4* rope;
    __device__ __forceinline__ void operator()(const f32x4 (&acc)[2][2][4][2], const Unit& u, int wr, int wc, int fr, int fq) const {
        const int pn = u.pn;
        float rs[2][4];
#pragma unroll
        for (int ai = 0; ai < 2; ++ai)
#pragma unroll
            for (int m = 0; m < 4; ++m) { rs[ai][m] = 1.f; if (mode != 2) rs[ai][m] = ss[u.pm * 256 + ai * 128 + wr * 64 + m * 16 + fr]; }
        const bool rot = (mode == 0) && (pn < 8);
#pragma unroll
        for (int aig = 0; aig < 4; ++aig) { const int ai = aig >> 1, mg = (aig & 1) * 2;
            f32x4 rp[4][2][2];
            if (rot) {
#pragma unroll
                for (int m = mg; m < mg + 2; ++m)
#pragma unroll
                    for (int bj = 0; bj < 2; ++bj) { const int row = u.pm * 256 + ai * 128 + wr * 64 + m * 16 + fr, col0 = pn * 256 + bj * 128 + wc * 32 + 8 * fq;
                        const f32x4* p_ = rope + (size_t)row * 64 + ((col0 & 255) >> 2); rp[m][bj][0] = p_[0]; rp[m][bj][1] = p_[1]; }
            }
#pragma unroll
            for (int m = mg; m < mg + 2; ++m) {
                const int row = u.pm * 256 + ai * 128 + wr * 64 + m * 16 + fr;
                float r_ = 1.f; if (mode != 2) r_ = rstd_of(rs[ai][m], 1.f / 2048.f);
#pragma unroll
                for (int bj = 0; bj < 2; ++bj) {
                    const int col0 = pn * 256 + bj * 128 + wc * 32 + 8 * fq;
                    f32x4 v0 = acc[ai][bj][m][0] * r_, v1 = acc[ai][bj][m][1] * r_;
                    if (mode == 0) {
                        if (pn < 8) {
                            const f32x4 c01 = rp[m][bj][0], c23 = rp[m][bj][1];
                            f32x4 r0, r1;
                            r0[0] = v0[0] * c01[0] - v0[1] * c01[1]; r0[1] = v0[0] * c01[1] + v0[1] * c01[0];
                            r0[2] = v0[2] * c01[2] - v0[3] * c01[3]; r0[3] = v0[2] * c01[3] + v0[3] * c01[2];
                            r1[0] = v1[0] * c23[0] - v1[1] * c23[1]; r1[1] = v1[0] * c23[1] + v1[1] * c23[0];
                            r1[2] = v1[2] * c23[2] - v1[3] * c23[3]; r1[3] = v1[2] * c23[3] + v1[3] * c23[2];
                            v0 = r0; v1 = r1;
                            if (pn >= 4) { v0 = v0 * 0.0625f; v1 = v1 * 0.0625f; }
                        } else if (pn == 16 || pn == 17) { v0 = v0 * 0.08838834764831845f; v1 = v1 * 0.08838834764831845f; }
                    } else if (mode == 1) { if (pn < 8) { v0 = v0 * 0.08838834764831845f; v1 = v1 * 0.08838834764831845f; } }
                    if (mode == 0 && pn == 28) {
                        if (bj == 0 && wc == 0 && fq < 2) { *(f32x4*)(GLR + (size_t)row * 16 + 8 * fq) = v0; *(f32x4*)(GLR + (size_t)row * 16 + 8 * fq + 4) = v1; }
                    } else {
                        u32x4 w; w.x = cvt_pk_bf16(v0[0], v0[1]); w.y = cvt_pk_bf16(v0[2], v0[3]); w.z = cvt_pk_bf16(v1[0], v1[1]); w.w = cvt_pk_bf16(v1[2], v1[3]);
                        *(u32x4*)(O + (size_t)row * ldo + col0) = w;
                    }
                }
            }
        }
    }
};
struct EpiSwiglu {
    static constexpr bool PERM = true, AFTER_DRAIN = false;
    bf16_t* ACT; const float* ss;
    __device__ __forceinline__ void operator()(const f32x4 (&acc)[2][2][4][2], const Unit& u, int wr, int wc, int fr, int fq) const {
        float rsv[2][4];
#pragma unroll
        for (int ai = 0; ai < 2; ++ai)
#pragma unroll
            for (int m = 0; m < 4; ++m) rsv[ai][m] = ss[u.pm * 256 + ai * 128 + wr * 64 + m * 16 + fr];
#pragma unroll
        for (int ai = 0; ai < 2; ++ai)
#pragma unroll
            for (int m = 0; m < 4; ++m) {
                const int row = u.pm * 256 + ai * 128 + wr * 64 + m * 16 + fr;
                const float rs = rstd_of(rsv[ai][m], 1.f / 2048.f);
                float o[8];
#pragma unroll
                for (int n = 0; n < 2; ++n)
#pragma unroll
                    for (int j = 0; j < 4; ++j) { const float g = acc[ai][0][m][n][j] * rs, up = acc[ai][1][m][n][j] * rs; o[n * 4 + j] = silu_f(g) * up; }
                u32x4 w; w.x = cvt_pk_bf16(o[0], o[1]); w.y = cvt_pk_bf16(o[2], o[3]); w.z = cvt_pk_bf16(o[4], o[5]); w.w = cvt_pk_bf16(o[6], o[7]);
                *(u32x4*)(ACT + (size_t)row * FFH + u.pn * 128 + wc * 32 + 8 * fq) = w;
            }
    }
};
struct EpiRes {
    static constexpr bool PERM = true, AFTER_DRAIN = false;
    int ple; const bf16_t* base; bf16_t* xb; float* ss_out; const float* ss_in; const bf16_t* pp;
    __device__ __forceinline__ void operator()(const f32x4 (&acc)[2][2][4][2], const Unit& u, int wr, int wc, int fr, int fq) const {
        float rsv[2][4];
#pragma unroll
        for (int ai = 0; ai < 2; ++ai)
#pragma unroll
            for (int m = 0; m < 4; ++m) { rsv[ai][m] = 0.f; if (ple) rsv[ai][m] = ss_in[u.pm * 256 + ai * 128 + wr * 64 + m * 16 + fr]; }
#pragma unroll
        for (int aig = 0; aig < 4; ++aig) { const int ai = aig >> 1, mg = (aig & 1) * 2;
            u32x4 bwv[4][2], pwv[4][2];
#pragma unroll
            for (int m = mg; m < mg + 2; ++m)
#pragma unroll
                for (int bj = 0; bj < 2; ++bj) { const size_t off = (size_t)(u.pm * 256 + ai * 128 + wr * 64 + m * 16 + fr) * DM + u.pn * 256 + bj * 128 + wc * 32 + 8 * fq;
                    bwv[m][bj] = *(const u32x4*)(base + off); pwv[m][bj] = (u32x4){0u, 0u, 0u, 0u}; if (ple) pwv[m][bj] = *(const u32x4*)(pp + off); }
#pragma unroll
            for (int m = mg; m < mg + 2; ++m) {
                const int row = u.pm * 256 + ai * 128 + wr * 64 + m * 16 + fr;
                float rs = 1.f; if (ple) rs = rstd_of(rsv[ai][m], 1.f / 2048.f);
                float sq = 0.f;
#pragma unroll
                for (int bj = 0; bj < 2; ++bj) {
                    const size_t off = (size_t)row * DM + u.pn * 256 + bj * 128 + wc * 32 + 8 * fq;
                    const u32x4 bw = bwv[m][bj];
                    float v[8] = {acc[ai][bj][m][0][0], acc[ai][bj][m][0][1], acc[ai][bj][m][0][2], acc[ai][bj][m][0][3], acc[ai][bj][m][1][0], acc[ai][bj][m][1][1], acc[ai][bj][m][1][2], acc[ai][bj][m][1][3]};
                    if (ple) { const u32x4 pw = pwv[m][bj];
                        const float pf[8] = {bflo(pw.x), bfhi(pw.x), bflo(pw.y), bfhi(pw.y), bflo(pw.z), bfhi(pw.z), bflo(pw.w), bfhi(pw.w)};
#pragma unroll
                        for (int j = 0; j < 8; ++j) v[j] = sigmoid_f(v[j] * rs) * pf[j]; }
                    const float bf[8] = {bflo(bw.x), bfhi(bw.x), bflo(bw.y), bfhi(bw.y), bflo(bw.z), bfhi(bw.z), bflo(bw.w), bfhi(bw.w)};
#pragma unroll
                    for (int j = 0; j < 8; ++j) { v[j] += bf[j]; sq += v[j] * v[j]; }
                    u32x4 w; w.x = cvt_pk_bf16(v[0], v[1]); w.y = cvt_pk_bf16(v[2], v[3]); w.z = cvt_pk_bf16(v[4], v[5]); w.w = cvt_pk_bf16(v[6], v[7]);
                    *(u32x4*)(xb + off) = w;
                }
                sq += __shfl_xor(sq, 16); sq += __shfl_xor(sq, 32);
                if (fq == 0) unsafeAtomicAdd(ss_out + row, sq);
            }
        }
    }
};

__device__ __forceinline__ void conv_weight(LAS unsigned* scr, const float* W, int K, int N, bf16_t* WT, const float* kscale, int mode, int first, int ngw, int lane) {
    const int nblk = (N + 63) >> 6, nitems = nblk * (K >> 6);
    const int g = lane >> 4, n4 = (lane & 15) * 4;
    for (int it = first; it < nitems; it += ngw) {
        const int kb = it / nblk, nb = it - kb * nblk, k0 = kb << 6, n0 = nb << 6;
        const bool ok = (n0 + n4) < N;
        f32x4 v[16];
#pragma unroll
        for (int i = 0; i < 16; ++i) { const int k = 8 * (i >> 1) + 2 * g + (i & 1); v[i] = (f32x4){0.f, 0.f, 0.f, 0.f}; if (ok) v[i] = *(const f32x4*)(W + (size_t)(k0 + k) * N + n0 + n4); }
        if (kscale) {
#pragma unroll
            for (int i = 0; i < 16; ++i) { const int k = 8 * (i >> 1) + 2 * g + (i & 1); v[i] = v[i] * kscale[k0 + k]; } }
#pragma unroll
        for (int m = 0; m < 8; ++m)
#pragma unroll
            for (int j = 0; j < 4; ++j) scr[(n4 + j) * 33 + 4 * m + g] = cvt_pk_bf16(v[2 * m][j], v[2 * m + 1][j]);
        LDS_WAIT();
        const int c = lane & 7;
#pragma unroll
        for (int jr = 0; jr < 8; ++jr) { const int nl = (lane >> 3) + 8 * jr, n = n0 + nl; const LAS unsigned* sp = scr + nl * 33 + 4 * c;
            const u32x4 o = {sp[0], sp[1], sp[2], sp[3]};
            int dr = n; if (mode == 1) dr = ((n >> 7) << 8) + (n & 127); else if (mode == 2) dr = ((n >> 7) << 8) + 128 + (n & 127);
            if (n < N) *(u32x4*)(WT + (size_t)dr * K + k0 + 8 * c) = o; }
        LDS_WAIT();
    }
}

typedef short v4i16_t __attribute__((ext_vector_type(4)));
__device__ __forceinline__ u32x2 lds_tr16(const LAS bf16_t* p) { return __builtin_bit_cast(u32x2, __builtin_amdgcn_ds_read_tr16_b64_v4i16((LAS v4i16_t*)p)); }
#define LBAR() do { asm volatile("s_waitcnt lgkmcnt(0)" ::: "memory"); __builtin_amdgcn_s_barrier(); asm volatile("" ::: "memory"); } while (0)
template <int DK, bool GLA>
__device__ __forceinline__ void mixer_unit(ldsp lds, int b, int h, int es, const bf16_t* Z, const float* GLR, const float* gate_up, const float* gate_b, bf16_t* Oraw, int tid) {
    constexpr int LQ = DK + 16, LT = 72, LVM = 80, NP = DK / 64, PPR = DK / 8, NT = DK / 32;
    constexpr int OFF_Q = 0, OFF_K = OFF_Q + 64 * LQ * 2, OFF_ST = OFF_K + 64 * LQ * 2, OFF_V = OFF_ST + 64 * LQ * 2, OFF_VD = OFF_V + 64 * LVM * 2, OFF_S = OFF_VD + 64 * LVM * 2, OFF_X = OFF_S + 64 * LT * 2;
    constexpr int OFF_CUM = OFF_X, OFF_SEGT = OFF_CUM + 64 * 128 * 4, OFF_EL = OFF_SEGT + 4 * 128 * 4, OFF_GLR = OFF_EL + 128 * 4, OFF_GU = OFF_GLR + 64 * 16 * 4, OFF_GB = OFF_GU + 16 * 128 * 4, OFF_ENDX = OFF_GB + 128 * 4;
    static_assert((GLA ? OFF_ENDX : OFF_X) <= LDS_BYTES, "mixer LDS");
    const int w = __builtin_amdgcn_readfirstlane(tid >> 6), lane = tid & 63, fr = lane & 15, fq = lane >> 4;
    const int qoff = GLA ? 4096 + h * 128 : h * 256, koff = GLA ? 4608 + h * 128 : 1024 + h * 256, voff = (GLA ? 5120 : 2048) + h * 256 + es * 64, ocol = (GLA ? 1024 : 0) + h * 256 + es * 64;
    const float lg = (h == 0) ? -0.0317486983145803f : (h == 1) ? -0.015748356968139168f : (h == 2) ? -0.007843177461025893f : -0.003913899321136329f;
    LAS bf16_t* Qs = (LAS bf16_t*)(lds + OFF_Q); LAS bf16_t* Ks = (LAS bf16_t*)(lds + OFF_K); LAS bf16_t* Vds = (LAS bf16_t*)(lds + OFF_VD);
    LAS bf16_t* Vs = (LAS bf16_t*)(lds + OFF_V); LAS bf16_t* Ss = (LAS bf16_t*)(lds + OFF_S); LAS bf16_t* STs = (LAS bf16_t*)(lds + OFF_ST);
    LAS float* CUM = (LAS float*)(lds + OFF_CUM); LAS float* SEGT = (LAS float*)(lds + OFF_SEGT); LAS float* EL = (LAS float*)(lds + OFF_EL);
    LAS float* GLRs = (LAS float*)(lds + OFF_GLR); LAS float* GU = (LAS float*)(lds + OFF_GU); LAS float* GB = (LAS float*)(lds + OFF_GB);
    for (int i = tid; i < 64 * LQ * 2 / 16; i += 512) ((LAS u32x4*)STs)[i] = (u32x4){0u, 0u, 0u, 0u};
    if (GLA) { for (int i = tid; i < 16 * 128; i += 512) GU[i] = gate_up[(size_t)(i >> 7) * 512 + h * 128 + (i & 127)]; if (tid < 128) GB[tid] = gate_b[h * 128 + tid]; }
    f32x4 st[NT];
#pragma unroll
    for (int t = 0; t < NT; ++t) st[t] = (f32x4){0.f, 0.f, 0.f, 0.f};
    u32x4 rq[NP], rk[NP], rv;
    const int vrow = tid >> 3, vpc = tid & 7;
    {   const size_t tb = (size_t)b * SEQ;
#pragma unroll
        for (int i = 0; i < NP; ++i) { const int p = tid + 512 * i, row = p / PPR, pc = p % PPR; rq[i] = *(const u32x4*)(Z + (tb + row) * ZW + qoff + pc * 8); rk[i] = *(const u32x4*)(Z + (tb + row) * ZW + koff + pc * 8); }
        rv = *(const u32x4*)(Z + (tb + vrow) * ZW + voff + vpc * 8); }
    const int te = w & 3, ti0 = (w >> 2) * 2;
    const int tis = w >> 1, tj0 = (w & 1) * 2;
    const int tdb = (w >> 2) * NT;
    const int trq = fr >> 2, trp = fr & 3;
    float guv[16], gbv = 0.f; f32x2v rg = {0.f, 0.f};
    if (GLA) {
        rg = *(const f32x2v*)(GLR + (size_t)b * SEQ * 16 + tid * 2);
        *(LAS f32x2v*)(GLRs + tid * 2) = rg;
        LBAR();
#pragma unroll
        for (int r = 0; r < 16; ++r) guv[r] = GU[r * 128 + (tid & 127)];
        gbv = GB[tid & 127];
        {   const int d = tid & 127, seg = tid >> 7; float run = 0.f;
#pragma unroll 4
            for (int jj = 0; jj < 16; ++jj) { const int j = seg * 16 + jj; f32x2v ua2 = {gbv, 0.f};
#pragma unroll
                    for (int r = 0; r < 16; r += 2) { const f32x2v g2 = *(const LAS f32x2v*)(GLRs + j * 16 + r); ua2 += g2 * (f32x2v){guv[r], guv[r + 1]}; }
                    const float uacc = ua2.x + ua2.y;
                run += (fminf(uacc, 0.f) - __logf(1.f + __expf(-fabsf(uacc)))) * 0.0625f; CUM[j * 128 + d] = run; }
            SEGT[seg * 128 + d] = run; }
        rg = *(const f32x2v*)(GLR + ((size_t)b * SEQ + 64) * 16 + tid * 2);
        LBAR();
    } else {
#pragma unroll
        for (int r = 0; r < 16; ++r) guv[r] = 0.f; }
    for (int c = 0; c < 32; ++c) {
        const size_t tb = (size_t)b * SEQ + (size_t)c * 64;
        if (GLA) {
            if (c < 31) *(LAS f32x2v*)(GLRs + tid * 2) = rg;
            {   const int d = tid & 127, seg = tid >> 7; float off = 0.f;
                if (seg > 0) off += SEGT[d]; if (seg > 1) off += SEGT[128 + d]; if (seg > 2) off += SEGT[256 + d];
                if (seg > 0) {
#pragma unroll
                    for (int jj = 0; jj < 16; ++jj) CUM[(seg * 16 + jj) * 128 + d] += off; }
                if (seg == 3) EL[d] = __expf(CUM[63 * 128 + d]); }
            LBAR();
        }
#pragma unroll
        for (int i = 0; i < NP; ++i) { const int p = tid + 512 * i, row = p / PPR, pc = p % PPR;
            const unsigned qw[4] = {rq[i].x, rq[i].y, rq[i].z, rq[i].w}, kw[4] = {rk[i].x, rk[i].y, rk[i].z, rk[i].w};
            if (GLA) {
                unsigned qo[4], ko[4];
#pragma unroll
                for (int jj = 0; jj < 4; ++jj) { const int d = pc * 8 + 2 * jj;
                    const float c0 = CUM[row * 128 + d], c1 = CUM[row * 128 + d + 1], l0 = CUM[63 * 128 + d], l1 = CUM[63 * 128 + d + 1];
                    const float e0 = __expf(c0), e1 = __expf(c1), k0 = bflo(kw[jj]), k1 = bfhi(kw[jj]);
                    qo[jj] = cvt_pk_bf16(bflo(qw[jj]) * e0, bfhi(qw[jj]) * e1);
                    ko[jj] = cvt_pk_bf16(k0 * fast_rcp(e0), k1 * fast_rcp(e1));
                }
                *(LAS u32x4*)(Qs + row * LQ + pc * 8) = (u32x4){qo[0], qo[1], qo[2], qo[3]};
                *(LAS u32x4*)(Ks + row * LQ + pc * 8) = (u32x4){ko[0], ko[1], ko[2], ko[3]};
            } else {
                *(LAS u32x4*)(Qs + row * LQ + pc * 8) = rq[i];
                *(LAS u32x4*)(Ks + row * LQ + pc * 8) = rk[i];
            } }
        *(LAS u32x4*)(Vs + vrow * LVM + vpc * 8) = rv;
        if (!GLA) {
            const float kd = __expf((float)(63 - vrow) * lg);
            *(LAS u32x4*)(Vds + vrow * LVM + vpc * 8) = (u32x4){cvt_pk_bf16(bflo(rv.x) * kd, bfhi(rv.x) * kd), cvt_pk_bf16(bflo(rv.y) * kd, bfhi(rv.y) * kd), cvt_pk_bf16(bflo(rv.z) * kd, bfhi(rv.z) * kd), cvt_pk_bf16(bflo(rv.w) * kd, bfhi(rv.w) * kd)}; }
        LBAR();
        if (c < 31) { const size_t tn = tb + 64;
#pragma unroll
            for (int i = 0; i < NP; ++i) { const int p = tid + 512 * i, row = p / PPR, pc = p % PPR; rq[i] = *(const u32x4*)(Z + (tn + row) * ZW + qoff + pc * 8); rk[i] = *(const u32x4*)(Z + (tn + row) * ZW + koff + pc * 8); }
            rv = *(const u32x4*)(Z + (tn + vrow) * ZW + voff + vpc * 8);
        }
        if (GLA && c < 30) rg = *(const f32x2v*)(GLR + (tb + 128) * 16 + tid * 2);
        f32x4 o2a = {0.f, 0.f, 0.f, 0.f}, o2b = {0.f, 0.f, 0.f, 0.f};
        {   f32x4 s0 = {0.f, 0.f, 0.f, 0.f}, s1 = {0.f, 0.f, 0.f, 0.f};
#pragma unroll
            for (int ks = 0; ks < NT; ++ks) {
                const bf16x8 a = *(const LAS bf16x8*)(Qs + (16 * tis + fr) * LQ + 32 * ks + 8 * fq);
                const bf16x8 b0 = *(const LAS bf16x8*)(Ks + (16 * tj0 + fr) * LQ + 32 * ks + 8 * fq), b1 = *(const LAS bf16x8*)(Ks + (16 * tj0 + 16 + fr) * LQ + 32 * ks + 8 * fq);
                s0 = __builtin_amdgcn_mfma_f32_16x16x32_bf16(a, b0, s0, 0, 0, 0); s1 = __builtin_amdgcn_mfma_f32_16x16x32_bf16(a, b1, s1, 0, 0, 0);
                const bf16x8 sa = *(const LAS bf16x8*)(STs + (16 * te + fr) * LQ + 32 * ks + 8 * fq);
                const bf16x8 q0 = *(const LAS bf16x8*)(Qs + (16 * ti0 + fr) * LQ + 32 * ks + 8 * fq), q1 = *(const LAS bf16x8*)(Qs + (16 * ti0 + 16 + fr) * LQ + 32 * ks + 8 * fq);
                o2a = __builtin_amdgcn_mfma_f32_16x16x32_bf16(sa, q0, o2a, 0, 0, 0); o2b = __builtin_amdgcn_mfma_f32_16x16x32_bf16(sa, q1, o2b, 0, 0, 0);
            }
#pragma unroll
            for (int r = 0; r < 4; ++r) { const int i = 16 * tis + 4 * fq + r, j = 16 * tj0 + fr;
                float m0, m1;
                if (GLA) { m0 = (i >= j) ? 1.f : 0.f; m1 = (i >= j + 16) ? 1.f : 0.f; }
                else { m0 = (i >= j) ? __expf((float)(i - j) * lg) : 0.f; m1 = (i >= j + 16) ? __expf((float)(i - j - 16) * lg) : 0.f; }
                Ss[i * LT + j] = f2bf(m0 != 0.f ? s0[r] * m0 : 0.f); Ss[i * LT + j + 16] = f2bf(m1 != 0.f ? s1[r] * m1 : 0.f); }
        }
        LBAR();
        if (GLA && c < 31) {
            {   const int d = tid & 127, seg = tid >> 7; float run = 0.f;
#pragma unroll 4
                for (int jj = 0; jj < 16; ++jj) { const int j = seg * 16 + jj; f32x2v ua2 = {gbv, 0.f};
#pragma unroll
                    for (int r = 0; r < 16; r += 2) { const f32x2v g2 = *(const LAS f32x2v*)(GLRs + j * 16 + r); ua2 += g2 * (f32x2v){guv[r], guv[r + 1]}; }
                    const float uacc = ua2.x + ua2.y;
                    run += (fminf(uacc, 0.f) - __logf(1.f + __expf(-fabsf(uacc)))) * 0.0625f; CUM[j * 128 + d] = run; }
                SEGT[seg * 128 + d] = run; }
        }
        {   f32x4 o1a = {0.f, 0.f, 0.f, 0.f}, o1b = {0.f, 0.f, 0.f, 0.f};
            bf16x8 vf[2], vdf[2];
#pragma unroll
            for (int ks = 0; ks < 2; ++ks) {
                const LAS bf16_t* vp = Vs + (32 * ks + 8 * fq + trq) * LVM + 16 * te + 4 * trp;
                const u32x2 vlo = lds_tr16(vp), vhi = lds_tr16(vp + 4 * LVM);
                vf[ks] = __builtin_bit_cast(bf16x8, (u32x4){vlo.x, vlo.y, vhi.x, vhi.y});
                if (!GLA) { const LAS bf16_t* dp = Vds + (32 * ks + 8 * fq + trq) * LVM + 16 * te + 4 * trp; const u32x2 dlo = lds_tr16(dp), dhi = lds_tr16(dp + 4 * LVM); vdf[ks] = __builtin_bit_cast(bf16x8, (u32x4){dlo.x, dlo.y, dhi.x, dhi.y}); } else vdf[ks] = vf[ks];
                const bf16x8 b0 = *(const LAS bf16x8*)(Ss + (16 * ti0 + fr) * LT + 32 * ks + 8 * fq), b1 = *(const LAS bf16x8*)(Ss + (16 * ti0 + 16 + fr) * LT + 32 * ks + 8 * fq);
                o1a = __builtin_amdgcn_mfma_f32_16x16x32_bf16(vf[ks], b0, o1a, 0, 0, 0); o1b = __builtin_amdgcn_mfma_f32_16x16x32_bf16(vf[ks], b1, o1b, 0, 0, 0);
            }
            const int ia = 16 * ti0 + fr, ib = ia + 16;
            const float qa = GLA ? 1.f : __expf((float)(ia + 1) * lg), qb = GLA ? 1.f : __expf((float)(ib + 1) * lg);
            const f32x4 oa = o1a + o2a * qa, ob = o1b + o2b * qb;
            u32x2 wa, wb; wa.x = cvt_pk_bf16(oa[0], oa[1]); wa.y = cvt_pk_bf16(oa[2], oa[3]); wb.x = cvt_pk_bf16(ob[0], ob[1]); wb.y = cvt_pk_bf16(ob[2], ob[3]);
            *(u32x2*)(Oraw + (tb + ia) * DM + ocol + 16 * te + 4 * fq) = wa;
            *(u32x2*)(Oraw + (tb + ib) * DM + ocol + 16 * te + 4 * fq) = wb;
            const float cd = __expf(64.f * lg);
#pragma unroll
            for (int t = 0; t < NT; ++t) { const int td = tdb + t;
                if (!GLA) st[t] = st[t] * cd;
#pragma unroll
                for (int ks = 0; ks < 2; ++ks) { const LAS bf16_t* kp = Ks + (32 * ks + 8 * fq + trq) * LQ + 16 * td + 4 * trp;
                    const u32x2 klo = lds_tr16(kp), khi = lds_tr16(kp + 4 * LQ);
                    st[t] = __builtin_amdgcn_mfma_f32_16x16x32_bf16(__builtin_bit_cast(bf16x8, (u32x4){klo.x, klo.y, khi.x, khi.y}), vdf[ks], st[t], 0, 0, 0); }
                if (GLA) { const f32x4 el = *(const LAS f32x4*)(EL + 16 * td + 4 * fq); st[t] = st[t] * el; }
                u32x2 sw; sw.x = cvt_pk_bf16(st[t][0], st[t][1]); sw.y = cvt_pk_bf16(st[t][2], st[t][3]);
                *(LAS u32x2*)(STs + (16 * te + fr) * LQ + 16 * td + 4 * fq) = sw; }
        }
        LBAR();
    }
}

struct AttnItem { int b, head, br, rr, c, n; };
__device__ __forceinline__ AttnItem attn_decode(int item) { AttnItem t; const int bh = item / 48, rem = item - bh * 48, cn = rem & 15; t.br = rem >> 4; const int sh = 2 * t.br; t.rr = 1 << sh; t.c = cn & (t.rr - 1); t.n = cn >> sh; t.b = bh >> 4; t.head = bh & 15; return t; }
constexpr int ATT_LK = 136, ATT_LV = 144, ATT_OFF_VS = 256 * ATT_LK * 2;
static_assert(ATT_OFF_VS + 272 * ATT_LV * 2 <= LDS_BYTES, "attention LDS");
__device__ __forceinline__ void attn_load(const AttnItem& t, const bf16_t* QKV, u32x4 (&kr)[8], u32x4 (&vr)[8], int tid) {
    const size_t rowb = (size_t)t.b * SEQ;
#pragma unroll
    for (int i = 0; i < 8; ++i) { const int p = tid + 512 * i, kj = p >> 4, pc = p & 15, us = 128 * (t.n - 1) + kj;
        kr[i] = (u32x4){0u, 0u, 0u, 0u}; vr[i] = (u32x4){0u, 0u, 0u, 0u};
        if (us >= 0) { const size_t row = rowb + (size_t)us * t.rr + t.c; kr[i] = *(const u32x4*)(QKV + row * QKVW + 2048 + t.head * 128 + pc * 8); vr[i] = *(const u32x4*)(QKV + row * QKVW + 4096 + t.head * 128 + pc * 8); } }
}
__device__ __forceinline__ void attn_phase(ldsp lds, const bf16_t* QKV, bf16_t* OB0, bf16_t* OB1, bf16_t* OB2, float* LSE, int tid) {
    constexpr int LK = ATT_LK, LV = ATT_LV;
    const int w = __builtin_amdgcn_readfirstlane(tid >> 6), lane = tid & 63, fr = lane & 15, fq = lane >> 4;
    LAS bf16_t* Ks = (LAS bf16_t*)lds; LAS bf16_t* Vs = (LAS bf16_t*)(lds + ATT_OFF_VS);
    const int G = gridDim.x;
    int item = blockIdx.x;
    if (item >= 6144) return;
    if (tid < 256) *(LAS u32x4*)(Vs + (256 + (tid >> 4)) * LV + (tid & 15) * 8) = (u32x4){0u, 0u, 0u, 0u};
    u32x4 kr[8], vr[8];
    AttnItem t = attn_decode(item);
    attn_load(t, QKV, kr, vr, tid);
    bf16x8 qn[4];
    {   const size_t qr0 = (size_t)t.b * SEQ + (size_t)(128 * t.n + 16 * w + fr) * t.rr + t.c;
#pragma unroll
        for (int ks = 0; ks < 4; ++ks) qn[ks] = *(const bf16x8*)(QKV + qr0 * QKVW + t.head * 128 + 32 * ks + 8 * fq); }
    for (;;) {
        bf16_t* OB = t.br == 0 ? OB0 : (t.br == 1 ? OB1 : OB2);
        const int qi = 16 * w + fr;
        const size_t qrow = (size_t)t.b * SEQ + (size_t)(128 * t.n + qi) * t.rr + t.c;
        const int n_cur = t.n, head = t.head, br = t.br;
        bf16x8 qf[4];
#pragma unroll
        for (int ks = 0; ks < 4; ++ks) qf[ks] = qn[ks];
#pragma unroll
        for (int i = 0; i < 8; ++i) { const int p = tid + 512 * i, kj = p >> 4, pc = p & 15; *(LAS u32x4*)(Ks + kj * LK + pc * 8) = kr[i]; *(LAS u32x4*)(Vs + kj * LV + pc * 8) = vr[i]; }
        asm volatile("s_waitcnt lgkmcnt(0)" ::: "memory"); __builtin_amdgcn_s_barrier(); asm volatile("" ::: "memory");
        const int nxt = item + G; const bool has_next = nxt < 6144;
        if (has_next) { t = attn_decode(nxt); attn_load(t, QKV, kr, vr, tid);
            const size_t qr1 = (size_t)t.b * SEQ + (size_t)(128 * t.n + 16 * w + fr) * t.rr + t.c;
#pragma unroll
            for (int ks = 0; ks < 4; ++ks) qn[ks] = *(const bf16x8*)(QKV + qr1 * QKVW + t.head * 128 + 32 * ks + 8 * fq); }
        f32x4 s[9];
#pragma unroll
        for (int tt = 0; tt < 9; ++tt) { s[tt] = (f32x4){0.f, 0.f, 0.f, 0.f};
#pragma unroll
            for (int ks = 0; ks < 4; ++ks) { const bf16x8 a = *(const LAS bf16x8*)(Ks + (16 * (w + tt) + fr) * LK + 32 * ks + 8 * fq); s[tt] = __builtin_amdgcn_mfma_f32_16x16x32_bf16(a, qf[ks], s[tt], 0, 0, 0); } }
        float mx = -INFINITY;
#pragma unroll
        for (int tt = 0; tt < 9; ++tt)
#pragma unroll
            for (int r = 0; r < 4; ++r) { const int kj = 16 * (w + tt) + 4 * fq + r; const bool ok = (kj >= qi) && (kj <= qi + 128) && (n_cur > 0 || kj >= 128); s[tt][r] = ok ? s[tt][r] : -INFINITY; mx = fmaxf(mx, s[tt][r]); }
        mx = fmaxf(mx, __shfl_xor(mx, 16)); mx = fmaxf(mx, __shfl_xor(mx, 32));
        float den = 0.f;
#pragma unroll
        for (int tt = 0; tt < 9; ++tt)
#pragma unroll
            for (int r = 0; r < 4; ++r) { const float pv = __builtin_amdgcn_exp2f((s[tt][r] - mx) * 1.4426950408889634f); s[tt][r] = pv; den += pv; }
        den += __shfl_xor(den, 16); den += __shfl_xor(den, 32);
        bf16x8 P[5];
#pragma unroll
        for (int pp = 0; pp < 5; ++pp) { u32x4 pw; pw.x = cvt_pk_bf16(s[2 * pp][0], s[2 * pp][1]); pw.y = cvt_pk_bf16(s[2 * pp][2], s[2 * pp][3]);
            if (pp < 4) { pw.z = cvt_pk_bf16(s[2 * pp + 1][0], s[2 * pp + 1][1]); pw.w = cvt_pk_bf16(s[2 * pp + 1][2], s[2 * pp + 1][3]); } else { pw.z = 0u; pw.w = 0u; }
            P[pp] = __builtin_bit_cast(bf16x8, pw); }
        const float rden = 1.f / den;
        const LAS bf16_t* vbase = Vs + (16 * w + 4 * fq + (fr >> 2)) * LV + 4 * (fr & 3);
#pragma unroll
        for (int te = 0; te < 8; ++te) { f32x4 o = {0.f, 0.f, 0.f, 0.f};
#pragma unroll
            for (int pp = 0; pp < 5; ++pp) {
                const u32x2 lo = lds_tr16(vbase + (32 * pp) * LV + 16 * te), hi = lds_tr16(vbase + (32 * pp + 16) * LV + 16 * te);
                const u32x4 aw = {lo.x, lo.y, hi.x, hi.y};
                o = __builtin_amdgcn_mfma_f32_16x16x32_bf16(__builtin_bit_cast(bf16x8, aw), P[pp], o, 0, 0, 0); }
            o = o * rden; u32x2 ow; ow.x = cvt_pk_bf16(o[0], o[1]); ow.y = cvt_pk_bf16(o[2], o[3]);
            *(u32x2*)(OB + qrow * DM + head * 128 + 16 * te + 4 * fq) = ow; }
        if (fq == 0) LSE[(size_t)br * M_TOK * 16 + qrow * 16 + head] = mx + __logf(den);
        asm volatile("s_waitcnt lgkmcnt(0)" ::: "memory"); __builtin_amdgcn_s_barrier(); asm volatile("" ::: "memory");
        if (!has_next) break;
        item = nxt;
    }
}

struct Args {
    const float* x; const float* p; const int* positions; const float* attn_norm_w; const float* ffn_norm_w; const float* ple_norm_w; const float* final_norm_w;
    const float* ab_w_in; const float* ab_gate_up; const float* ab_gate_b; const float* ab_ret_norm_w; const float* ab_gla_norm_w; const float* ab_w_out;
    const float* c_w_qkv; const float* c_w_out; const float* ffn_w_gate; const float* ffn_w_up; const float* ffn_w_down; const float* ple_w_proj; const float* ple_w_gate;
    float* out; unsigned char* ws; int st_lo, st_hi;
};
__device__ __forceinline__ float wave_sum(float v) {
#pragma unroll
    for (int o = 1; o < 64; o <<= 1) v += __shfl_xor(v, o);
    return v;
}
enum { K_NONE = 0, K_PROLOGUE, K_GPROJ, K_GSWI, K_GRES, K_MIXER, K_NORMPASS, K_CONV, K_ATTN, K_MERGE, K_FINAL };
constexpr int N_STEPS = 19;
#ifndef DBG_HI
#define DBG_HI N_STEPS
#endif

#define WSP(type, off) ((type*)(ws + (off)))
#ifdef DUP_SYNC
#define DUP_SYNC_STMT xcd_barrier(xbar);
#else
#define DUP_SYNC_STMT
#endif
#define IN(k) (st_lo <= (k) && (k) < st_hi)
#define SYNC_AFTER(k) do { if (IN(k) && IN((k) + 1)) { xcd_barrier(xbar); DUP_SYNC_STMT } } while (0)
#define RUN_GEMM(EPI, NN, e) do { pg8::StaticOrder S_; S_.init(M_TOK, (NN), (int)gridDim.x, (int)blockIdx.x); pg8::gemm_phase<EPI, pg8::StaticOrder, true, true>(lds, g, S_, e); } while (0)

#define XB_TMO      128
#define XB_XCNT(j)  (256  + 64 * (j))
#define XB_XSUB(j)  (1280 + 64 * (j))
#define XB_XGEN(j)  (2304 + 64 * (j))
#define XB_TOP      3328
#define XB_TOPGEN   3392
#define XCD_BAR_WORDS 3456
#define XB_SPIN_CAP (1u << 18)

__device__ __forceinline__ unsigned xb_ld(unsigned* p)              { return __hip_atomic_load(p, __ATOMIC_RELAXED, __HIP_MEMORY_SCOPE_AGENT); }
__device__ __forceinline__ unsigned xb_add(unsigned* p, unsigned v) { return __hip_atomic_fetch_add(p, v, __ATOMIC_RELAXED, __HIP_MEMORY_SCOPE_AGENT); }
__device__ __forceinline__ unsigned xb_xcc_id() { return (unsigned)__builtin_amdgcn_s_getreg((3 << 11) | 20) & 0xFu; }
#define XB_SPIN(cond, bar) do { unsigned _sp = 0; while (cond) { __builtin_amdgcn_s_sleep(1); \
    if ((++_sp & 255u) == 0u) { if (xb_ld(&(bar)[XB_TMO])) break; if (_sp > XB_SPIN_CAP) { atomicAdd(&(bar)[XB_TMO], 1u); break; } } } } while (0)

struct XcdBarrier {
    unsigned* bar; unsigned x;
    volatile LAS unsigned* st;
};

__device__ __forceinline__ XcdBarrier xcd_barrier_post(unsigned* bar, volatile LAS unsigned* st) {
    XcdBarrier b; b.bar = bar; b.x = xb_xcc_id(); b.st = st;
    if (threadIdx.x == 0) (void)xb_add(&bar[XB_XCNT(b.x)], 1u);
    return b;
}
__device__ __forceinline__ void xcd_barrier_complete(unsigned* bar, unsigned x, unsigned& nloc, unsigned& nx) {
    const unsigned G = gridDim.x * gridDim.y * gridDim.z;
    unsigned sum, cnt, mine, sp = 0u;
    for (;;) {
        sum = 0u; cnt = 0u; mine = 0u;
#pragma unroll
        for (unsigned j = 0; j < 16; ++j) { const unsigned c = xb_ld(&bar[XB_XCNT(j)]); sum += c; cnt += (c > 0u) ? 1u : 0u; mine = (j == x) ? c : mine; }
        if (sum == G) break;
        __builtin_amdgcn_s_sleep(1);
        if ((++sp & 255u) == 0u) { if (xb_ld(&bar[XB_TMO])) break; if (sp > XB_SPIN_CAP) { atomicAdd(&bar[XB_TMO], 1u); break; } }
    }
    nloc = mine > 0u ? mine : 1u; nx = cnt > 0u ? cnt : 1u;
}

__device__ __forceinline__ void xcd_barrier(const XcdBarrier& b) {
    asm volatile("s_waitcnt vmcnt(0)" ::: "memory");
    __syncthreads();
    if (threadIdx.x == 0) {
        unsigned* bar = b.bar;
        __builtin_amdgcn_s_waitcnt(0);
        unsigned nloc = b.st[0], nx = b.st[1];
        if (nloc == 0u) { xcd_barrier_complete(bar, b.x, nloc, nx); b.st[0] = nloc; b.st[1] = nx; }
        const unsigned old = xb_add(&bar[XB_XSUB(b.x)], 1u);
        const unsigned gen = old / nloc;
        if (old + 1u == (gen + 1u) * nloc) {
            __builtin_amdgcn_fence(__ATOMIC_RELEASE, "agent");
            asm volatile("s_waitcnt vmcnt(0)" ::: "memory");
            const unsigned og = xb_add(&bar[XB_TOP], 1u);
            const unsigned tg = og / nx;
            if (og + 1u == (tg + 1u) * nx) xb_add(&bar[XB_TOPGEN], 1u);
            else XB_SPIN(xb_ld(&bar[XB_TOPGEN]) == tg, bar);
            xb_add(&bar[XB_XGEN(b.x)], 1u);
            __builtin_amdgcn_fence(__ATOMIC_ACQUIRE, "agent");
            asm volatile("s_waitcnt vmcnt(0)" ::: "memory");
        } else {
            XB_SPIN(xb_ld(&bar[XB_XGEN(b.x)]) == gen, bar);
            __builtin_amdgcn_fence(__ATOMIC_ACQUIRE, "agent");
            asm volatile("s_waitcnt vmcnt(0)" ::: "memory");
        }
    }
    __syncthreads();
}

constexpr size_t WS_WPP1 = 66 * MiB;
constexpr size_t WS_BAR = 512 * 1024;
constexpr int LDS_BARST = LDS_BYTES - 16;
__device__ __forceinline__ void conv_jobs(ldsp lds, const Args& a, int L, int lo, int hi, int wgrank, int nwg) {
    unsigned char* ws = a.ws;
    const int tid = threadIdx.x, lane = tid & 63, wave = __builtin_amdgcn_readfirstlane(tid >> 6), gw = wgrank * 8 + wave, ngw = nwg * 8;
    LAS unsigned* scr = (LAS unsigned*)(lds + wave * (64 * 33 * 4));
    int base = 0;
    for (int j = lo; j < hi; ++j) {
        const float* W = nullptr; int K = DM, N = DM, mode = 0; bf16_t* WT = nullptr; const float* ksc = nullptr;
        switch (j) {
            case 0: if (L == 0) { W = a.ab_w_in; N = INW; } else { W = a.c_w_qkv; N = QKVW; } WT = WSP(bf16_t, WS_WIN); ksc = a.attn_norm_w + L * DM; break;
            case 1: W = (L == 0) ? a.ab_w_out : a.c_w_out; WT = WSP(bf16_t, WS_WOUT); break;
            case 2: W = a.ffn_w_gate + (size_t)L * DM * FFH; N = FFH; WT = WSP(bf16_t, WS_WGU); ksc = a.ffn_norm_w + L * DM; mode = 1; break;
            case 3: W = a.ffn_w_up + (size_t)L * DM * FFH; N = FFH; WT = WSP(bf16_t, WS_WGU); ksc = a.ffn_norm_w + L * DM; mode = 2; break;
            case 4: W = a.ffn_w_down + (size_t)L * DM * FFH; K = FFH; WT = WSP(bf16_t, WS_WD); break;
            case 5: W = a.ple_w_gate + (size_t)L * DM * DM; WT = WSP(bf16_t, WS_WPG); ksc = a.ple_norm_w + L * DM; break;
            default: W = a.ple_w_proj + (size_t)L * 256 * DM; K = 256; WT = (L == 1) ? WSP(bf16_t, WS_WPP1) : WSP(bf16_t, WS_WPP); break;
        }
        const int nit = ((N + 63) >> 6) * (K >> 6);
        const int first = ((gw - base) % ngw + ngw) % ngw;
        conv_weight(scr, W, K, N, WT, ksc, mode, first, ngw, lane);
        base += nit;
    }
}

__global__ void __launch_bounds__(512, 2) fwd_megakernel(Args a) {
    extern __shared__ __attribute__((aligned(16))) unsigned char lds_raw[];
    cg::grid_group grid = cg::this_grid();
    ldsp lds = (ldsp)lds_raw;
    unsigned char* ws = a.ws;
    const int st_lo = a.st_lo, st_hi = a.st_hi;
    float* const SSX = WSP(float, WS_SS);
    if (threadIdx.x < 2) ((volatile LAS unsigned*)(lds + LDS_BARST))[threadIdx.x] = 0u;
    __syncthreads();
    if (st_lo > 4096) grid.sync();
    const XcdBarrier xbar = xcd_barrier_post((unsigned*)(ws + WS_BAR), (volatile LAS unsigned*)(lds + LDS_BARST));

    if (IN(0)) {
        const int tid = threadIdx.x, G = gridDim.x, bid = blockIdx.x;
        const float* xin = a.x; const float* pin = a.p; const int* pos = a.positions;
        bf16_t* XB0 = WSP(bf16_t, WS_XB0); bf16_t* PB = WSP(bf16_t, WS_PB); float* ROPE = WSP(float, WS_ROPE);
        const int lane = tid & 63, gw = bid * 8 + (tid >> 6), ngw = G * 8, gt = bid * 512 + tid, ngt = G * 512;
        for (int row = gw; row < M_TOK; row += ngw) { const float* xr = xin + (size_t)row * DM; float ssq = 0.f;
#pragma unroll
            for (int j = 0; j < 8; ++j) { const f32x4 v = *(const f32x4*)(xr + (lane + 64 * j) * 4); ssq += (v[0] * v[0] + v[1] * v[1]) + (v[2] * v[2] + v[3] * v[3]);
                u32x2 w; w.x = cvt_pk_bf16(v[0], v[1]); w.y = cvt_pk_bf16(v[2], v[3]); *(u32x2*)(XB0 + (size_t)row * DM + (lane + 64 * j) * 4) = w; }
            ssq = wave_sum(ssq); if (lane == 0) SSX[row] = ssq; }
        for (int t = gt; t < 2 * M_TOK * 256 / 8; t += ngt) { const f32x4 v0 = *(const f32x4*)(pin + (size_t)t * 8), v1 = *(const f32x4*)(pin + (size_t)t * 8 + 4);
            u32x4 w; w.x = cvt_pk_bf16(v0[0], v0[1]); w.y = cvt_pk_bf16(v0[2], v0[3]); w.z = cvt_pk_bf16(v1[0], v1[1]); w.w = cvt_pk_bf16(v1[2], v1[3]); *(u32x4*)(PB + (size_t)t * 8) = w; }
        for (int t = gt; t < M_TOK * 128; t += ngt) { const int row = t >> 7, i = t & 127;
            const float invf = 1.0f / exp2f(13.287712379549449f * ((float)i * (1.0f / 127.0f)));
            const float ang = (float)pos[row] * invf;
            double rev = (double)ang * 0.15915494309189535; rev -= floor(rev); const float rv = (float)rev;
            f32x2v cs; cs.x = __builtin_amdgcn_cosf(rv); cs.y = __builtin_amdgcn_sinf(rv); *(f32x2v*)(ROPE + (size_t)t * 2) = cs; }
        for (int t = gt; t < 6 * M_TOK; t += ngt) SSX[M_TOK + t] = 0.f;
        conv_jobs(lds, a, 0, 0, 7, (int)blockIdx.x, (int)gridDim.x);
        conv_jobs(lds, a, 1, 6, 7, (int)blockIdx.x, (int)gridDim.x);
#ifdef DUP_CONV
        conv_jobs(lds, a, 0, 0, 7, (int)blockIdx.x, (int)gridDim.x);
#endif
    }
    SYNC_AFTER(0);
    if (IN(1)) { pg8::Gemm g{WSP(bf16_t, WS_XB0), WSP(bf16_t, WS_WIN), M_TOK, INW_PAD, DM}; EpiProj e{0, WSP(bf16_t, WS_Z), ZW, WSP(float, WS_GLR), SSX, WSP(const f32x4, WS_ROPE)}; RUN_GEMM(EpiProj, INW_PAD, e); }
    if (IN(1)) { const int G1 = gridDim.x, nlong = ((M_TOK / 256) * (INW_PAD / 256)) % G1;
        const bool part = (nlong > 0 && 2 * nlong < G1); const int prank = part ? (int)blockIdx.x - nlong : (int)blockIdx.x, pnum = part ? G1 - nlong : G1;
        if (prank >= 0) { pg8::Gemm g{WSP(bf16_t, WS_PB), WSP(bf16_t, WS_WPP), M_TOK, DM, 256}; EpiProj e{2, (bf16_t*)a.out + (size_t)M_TOK * DM, DM, nullptr, nullptr, nullptr};
            pg8::StaticOrder S_; S_.init(M_TOK, DM, pnum, prank); pg8::gemm_phase<EpiProj, pg8::StaticOrder, true, true>(lds, g, S_, e); } }
    SYNC_AFTER(1);
    if (IN(2)) {
#ifndef NO_MIXER
        const int tid = threadIdx.x;
        const int G_ = gridDim.x;
        {
#ifndef NO_RET
#ifdef DUP_RET
        for (int rep_ = 0; rep_ < 2; ++rep_)
#endif
        for (int u = blockIdx.x; u < 128; u += G_) { mixer_unit<256, false>(lds, u >> 4, (u >> 2) & 3, u & 3, WSP(bf16_t, WS_Z), WSP(float, WS_GLR), a.ab_gate_up, a.ab_gate_b, WSP(bf16_t, WS_O), tid); __syncthreads(); }
#endif
#ifndef NO_GLA
#ifdef DUP_GLA
        for (int rep_ = 0; rep_ < 2; ++rep_)
#endif
        for (int v = (blockIdx.x + G_ - (128 % G_)) % G_; v < 128; v += G_) { mixer_unit<128, true>(lds, v >> 4, (v >> 2) & 3, v & 3, WSP(bf16_t, WS_Z), WSP(float, WS_GLR), a.ab_gate_up, a.ab_gate_b, WSP(bf16_t, WS_O), tid); __syncthreads(); }
#endif
        }
        if (G_ == 256) {
            const int u = blockIdx.x, v = u & 127, nb = v >> 4, nh = v & 15 >> 2, nes = v & 3, hd = (u < 128 ? 0 : 4) + ((v >> 2) & 3);
            unsigned* cnt = (unsigned*)(ws + WS_BAR) + 3520 + (u < 128 ? 0 : 32) + (v >> 2);
            asm volatile("s_waitcnt vmcnt(0)" ::: "memory"); __syncthreads();
            if (tid == 0) {
                __builtin_amdgcn_fence(__ATOMIC_RELEASE, "agent"); asm volatile("s_waitcnt vmcnt(0)" ::: "memory");
                __hip_atomic_fetch_add(cnt, 1u, __ATOMIC_RELAXED, __HIP_MEMORY_SCOPE_AGENT);
                unsigned sp = 0; while (__hip_atomic_load(cnt, __ATOMIC_RELAXED, __HIP_MEMORY_SCOPE_AGENT) < 4u) { __builtin_amdgcn_s_sleep(2); if (++sp > (1u << 20)) break; }
                __builtin_amdgcn_fence(__ATOMIC_ACQUIRE, "agent"); asm volatile("s_waitcnt vmcnt(0)" ::: "memory");
            }
            __syncthreads();
            (void)nh;
            bf16_t* OBUF = WSP(bf16_t, WS_O); const bf16_t* ZB = WSP(bf16_t, WS_Z);
            const int lane = tid & 63, wv = tid >> 6;
            const f32x4 nw = *(const f32x4*)((hd < 4 ? a.ab_ret_norm_w + hd * 256 : a.ab_gla_norm_w + (hd - 4) * 256) + lane * 4);
            const int gcol = (hd < 4 ? 3072 + hd * 256 : 6144 + (hd - 4) * 256) + lane * 4;
            for (int r0 = wv * 4; r0 < 512; r0 += 32) {
                u32x2 rw[4], gw4[4];
#pragma unroll
                for (int q = 0; q < 4; ++q) { const size_t row = (size_t)nb * SEQ + 512 * nes + r0 + q; rw[q] = *(const u32x2*)(OBUF + row * DM + hd * 256 + lane * 4); gw4[q] = *(const u32x2*)(ZB + row * ZW + gcol); }
#pragma unroll
                for (int q = 0; q < 4; ++q) { const size_t row = (size_t)nb * SEQ + 512 * nes + r0 + q;
                    const float x0 = bflo(rw[q].x), x1 = bfhi(rw[q].x), x2 = bflo(rw[q].y), x3 = bfhi(rw[q].y);
                    const float rs = rstd_of(wave_sum((x0 * x0 + x1 * x1) + (x2 * x2 + x3 * x3)), 1.f / 256.f);
                    u32x2 ow; ow.x = cvt_pk_bf16(x0 * rs * nw[0] * silu_f(bflo(gw4[q].x)), x1 * rs * nw[1] * silu_f(bfhi(gw4[q].x)));
                    ow.y = cvt_pk_bf16(x2 * rs * nw[2] * silu_f(bflo(gw4[q].y)), x3 * rs * nw[3] * silu_f(bfhi(gw4[q].y)));
                    *(u32x2*)(OBUF + row * DM + hd * 256 + lane * 4) = ow; }
            }
            __syncthreads();
        }
#endif
        {   const int G2 = gridDim.x; const bool split = (G2 == 256);
            const int prank = split ? ((int)blockIdx.x < 128 ? (int)blockIdx.x : -1) : (int)blockIdx.x, pnum = split ? 128 : G2;
            if (prank >= 0) { conv_jobs(lds, a, 1, 0, 1, prank, pnum); __syncthreads(); }
            pg8::Gemm g{WSP(bf16_t, WS_PB) + (size_t)M_TOK * 256, WSP(bf16_t, WS_WPP1), M_TOK, DM, 256}; EpiProj e{2, (bf16_t*)a.out, DM, nullptr, nullptr, nullptr};
            RUN_GEMM(EpiProj, DM, e);
        }
    }
    SYNC_AFTER(2);
    if (IN(3) && gridDim.x != 256) {
        bf16_t* OBUF = WSP(bf16_t, WS_O); const bf16_t* ZB = WSP(bf16_t, WS_Z);
        const int tid = threadIdx.x, lane = tid & 63, gw = blockIdx.x * 8 + (tid >> 6), ngw = gridDim.x * 8;
        const float* rnw = a.ab_ret_norm_w; const float* gnw = a.ab_gla_norm_w;
        for (int row = gw; row < M_TOK; row += ngw) {
            bf16_t* op = OBUF + (size_t)row * DM + lane * 4; const bf16_t* zp = ZB + (size_t)row * ZW + lane * 4;
            u32x2 rw[8], gwd[8]; f32x4 nw[8];
#pragma unroll
            for (int hd = 0; hd < 8; ++hd) { rw[hd] = *(const u32x2*)(op + hd * 256); gwd[hd] = *(const u32x2*)(zp + (hd < 4 ? 3072 + hd * 256 : 6144 + (hd - 4) * 256));
                nw[hd] = *(const f32x4*)((hd < 4 ? rnw + hd * 256 : gnw + (hd - 4) * 256) + lane * 4); }
#pragma unroll
            for (int hd = 0; hd < 8; ++hd) {
                const float r0 = bflo(rw[hd].x), r1 = bfhi(rw[hd].x), r2 = bflo(rw[hd].y), r3 = bfhi(rw[hd].y);
                const float ssq = wave_sum((r0 * r0 + r1 * r1) + (r2 * r2 + r3 * r3));
                const float rs = rstd_of(ssq, 1.f / 256.f);
                u32x2 ow; ow.x = cvt_pk_bf16(r0 * rs * nw[hd][0] * silu_f(bflo(gwd[hd].x)), r1 * rs * nw[hd][1] * silu_f(bfhi(gwd[hd].x)));
                ow.y = cvt_pk_bf16(r2 * rs * nw[hd][2] * silu_f(bflo(gwd[hd].y)), r3 * rs * nw[hd][3] * silu_f(bfhi(gwd[hd].y)));
                *(u32x2*)(op + hd * 256) = ow; } }
    }
    if (gridDim.x != 256) SYNC_AFTER(3);
    if (IN(4)) { pg8::Gemm g{WSP(bf16_t, WS_O), WSP(bf16_t, WS_WOUT), M_TOK, DM, DM}; EpiRes e{0, WSP(bf16_t, WS_XB0), WSP(bf16_t, WS_XB1), SSX + 1 * M_TOK, nullptr, nullptr}; RUN_GEMM(EpiRes, DM, e); }
#ifdef DUP_RES
    if (IN(4)) { pg8::Gemm g{WSP(bf16_t, WS_O), WSP(bf16_t, WS_WOUT), M_TOK, DM, DM}; EpiRes e{0, WSP(bf16_t, WS_XB0), WSP(bf16_t, WS_Z + 128 * MiB), WSP(float, WS_GLR), nullptr, nullptr}; RUN_GEMM(EpiRes, DM, e); }
#endif
    SYNC_AFTER(4);
#ifdef DUP_SWI
    if (IN(6)) { pg8::Gemm g{WSP(bf16_t, WS_XB1), WSP(bf16_t, WS_WGU), M_TOK, 2 * FFH, DM}; EpiSwiglu e{WSP(bf16_t, WS_Z), SSX + 1 * M_TOK}; RUN_GEMM(EpiSwiglu, 2 * FFH, e); }
#endif
    if (IN(6)) { pg8::Gemm g{WSP(bf16_t, WS_XB1), WSP(bf16_t, WS_WGU), M_TOK, 2 * FFH, DM}; EpiSwiglu e{WSP(bf16_t, WS_Z), SSX + 1 * M_TOK}; RUN_GEMM(EpiSwiglu, 2 * FFH, e); }
    SYNC_AFTER(6);
    if (IN(7)) { pg8::Gemm g{WSP(bf16_t, WS_Z), WSP(bf16_t, WS_WD), M_TOK, DM, FFH}; EpiRes e{0, WSP(bf16_t, WS_XB1), WSP(bf16_t, WS_XB0), SSX + 2 * M_TOK, nullptr, nullptr}; RUN_GEMM(EpiRes, DM, e); }
    SYNC_AFTER(7);
    if (IN(8)) { pg8::Gemm g{WSP(bf16_t, WS_XB0), WSP(bf16_t, WS_WPG), M_TOK, DM, DM}; EpiRes e{1, WSP(bf16_t, WS_XB0), WSP(bf16_t, WS_XB1), SSX + 3 * M_TOK, SSX + 2 * M_TOK, (const bf16_t*)a.out + (size_t)M_TOK * DM}; RUN_GEMM(EpiRes, DM, e); }
    SYNC_AFTER(8);
    if (IN(9) && (((int)blockIdx.x >> 3) & 1)) { conv_jobs(lds, a, 1, 1, 6, (int)blockIdx.x, (int)gridDim.x); __syncthreads(); }
    if (IN(9)) { pg8::Gemm g{WSP(bf16_t, WS_XB1), WSP(bf16_t, WS_WIN), M_TOK, QKVW, DM}; EpiProj e{1, WSP(bf16_t, WS_Z), QKVW, nullptr, SSX + 3 * M_TOK, nullptr}; RUN_GEMM(EpiProj, QKVW, e); }
    if (IN(9) && !(((int)blockIdx.x >> 3) & 1)) conv_jobs(lds, a, 1, 1, 6, (int)blockIdx.x, (int)gridDim.x);
    SYNC_AFTER(10);
    if (IN(11)) {
#ifndef NO_ATTN
        const int tid = threadIdx.x;
        attn_phase(lds, WSP(bf16_t, WS_Z), WSP(bf16_t, WS_XB0), (bf16_t*)a.out + (size_t)M_TOK * DM, WSP(bf16_t, WS_O), WSP(float, WS_LSE), tid);
#ifdef DUP_ATTN
        attn_phase(lds, WSP(bf16_t, WS_Z), WSP(bf16_t, WS_XB0), (bf16_t*)a.out + (size_t)M_TOK * DM, WSP(bf16_t, WS_O), WSP(float, WS_LSE), tid);
#endif
#endif
    }
    SYNC_AFTER(11);
    if (IN(12)) {
        const float* LSE = WSP(float, WS_LSE); const bf16_t* XB0 = WSP(bf16_t, WS_XB0); const bf16_t* XB1 = (const bf16_t*)a.out + (size_t)M_TOK * DM; bf16_t* OBUF = WSP(bf16_t, WS_O);
        const int tid = threadIdx.x, lane = tid & 63, gw = blockIdx.x * 8 + (tid >> 6), ngw = gridDim.x * 8;
        for (int row = gw; row < M_TOK; row += ngw) {
            u32x4 a0[4], a1[4], a2[4]; float l0[4], l1[4], l2[4];
#pragma unroll
            for (int i = 0; i < 4; ++i) { const int ch = lane + 64 * i, head = ch >> 4; const size_t off = (size_t)row * DM + ch * 8;
                a0[i] = *(const u32x4*)(XB0 + off); a1[i] = *(const u32x4*)(XB1 + off); a2[i] = *(const u32x4*)(OBUF + off);
                l0[i] = LSE[(size_t)row * 16 + head]; l1[i] = LSE[(size_t)M_TOK * 16 + (size_t)row * 16 + head]; l2[i] = LSE[(size_t)2 * M_TOK * 16 + (size_t)row * 16 + head]; }
#pragma unroll
            for (int i = 0; i < 4; ++i) { const int ch = lane + 64 * i; const size_t off = (size_t)row * DM + ch * 8;
                const float mx = fmaxf(l0[i], fmaxf(l1[i], l2[i])); float w0 = __expf(l0[i] - mx), w1 = __expf(l1[i] - mx), w2 = __expf(l2[i] - mx); const float inv = 1.f / (w0 + w1 + w2); w0 *= inv; w1 *= inv; w2 *= inv;
                u32x4 o;
                o.x = cvt_pk_bf16(w0 * bflo(a0[i].x) + w1 * bflo(a1[i].x) + w2 * bflo(a2[i].x), w0 * bfhi(a0[i].x) + w1 * bfhi(a1[i].x) + w2 * bfhi(a2[i].x));
                o.y = cvt_pk_bf16(w0 * bflo(a0[i].y) + w1 * bflo(a1[i].y) + w2 * bflo(a2[i].y), w0 * bfhi(a0[i].y) + w1 * bfhi(a1[i].y) + w2 * bfhi(a2[i].y));
                o.z = cvt_pk_bf16(w0 * bflo(a0[i].z) + w1 * bflo(a1[i].z) + w2 * bflo(a2[i].z), w0 * bfhi(a0[i].z) + w1 * bfhi(a1[i].z) + w2 * bfhi(a2[i].z));
                o.w = cvt_pk_bf16(w0 * bflo(a0[i].w) + w1 * bflo(a1[i].w) + w2 * bflo(a2[i].w), w0 * bfhi(a0[i].w) + w1 * bfhi(a1[i].w) + w2 * bfhi(a2[i].w));
                *(u32x4*)(OBUF + off) = o; } }
    }
    SYNC_AFTER(12);
    if (IN(13)) { pg8::Gemm g{WSP(bf16_t, WS_O), WSP(bf16_t, WS_WOUT), M_TOK, DM, DM}; EpiRes e{0, WSP(bf16_t, WS_XB1), WSP(bf16_t, WS_XB0), SSX + 4 * M_TOK, nullptr, nullptr}; RUN_GEMM(EpiRes, DM, e); }
    SYNC_AFTER(13);
    if (IN(15)) { pg8::Gemm g{WSP(bf16_t, WS_XB0), WSP(bf16_t, WS_WGU), M_TOK, 2 * FFH, DM}; EpiSwiglu e{WSP(bf16_t, WS_Z), SSX + 4 * M_TOK}; RUN_GEMM(EpiSwiglu, 2 * FFH, e); }
    SYNC_AFTER(15);
    if (IN(16)) { pg8::Gemm g{WSP(bf16_t, WS_Z), WSP(bf16_t, WS_WD), M_TOK, DM, FFH}; EpiRes e{0, WSP(bf16_t, WS_XB0), WSP(bf16_t, WS_XB1), SSX + 5 * M_TOK, nullptr, nullptr}; RUN_GEMM(EpiRes, DM, e); }
    SYNC_AFTER(16);
    if (IN(17)) { pg8::Gemm g{WSP(bf16_t, WS_XB1), WSP(bf16_t, WS_WPG), M_TOK, DM, DM}; EpiRes e{1, WSP(bf16_t, WS_XB1), WSP(bf16_t, WS_XB0), SSX + 6 * M_TOK, SSX + 5 * M_TOK, (const bf16_t*)a.out}; RUN_GEMM(EpiRes, DM, e); }
    SYNC_AFTER(17);
#ifdef DBG_DUMP
    { asm volatile("s_waitcnt vmcnt(0)" ::: "memory"); __syncthreads(); grid.sync();
      const bf16_t* src = (DBG_DUMP >= 4) ? WSP(bf16_t, WS_O) : WSP(bf16_t, WS_Z) + (DBG_DUMP - 1) * 2048; const int ld = (DBG_DUMP >= 4) ? 2048 : ZW;
      const int gt = blockIdx.x * 512 + threadIdx.x, ngt = gridDim.x * 512;
      for (int t = gt; t < M_TOK * 2048; t += ngt) { const int row = t >> 11, col = t & 2047; a.out[t] = bf2f(src[(size_t)row * ld + (DBG_DUMP == 5 ? (col & 1023) : DBG_DUMP == 6 ? 1024 + (col & 1023) : col)]); } }
#endif
    if (IN(18)) {
        float* outp = a.out; const float* fnw = a.final_norm_w; const bf16_t* xres = WSP(bf16_t, WS_XB0);
        const int tid = threadIdx.x, lane = tid & 63, gw = blockIdx.x * 8 + (tid >> 6), ngw = gridDim.x * 8;
        for (int row = gw; row < M_TOK; row += ngw) { u32x4 xw[4]; float ssq = 0.f; float v[4][8];
#pragma unroll
            for (int j = 0; j < 4; ++j) xw[j] = *(const u32x4*)(xres + (size_t)row * DM + (lane + 64 * j) * 8);
#pragma unroll
            for (int j = 0; j < 4; ++j) { v[j][0] = bflo(xw[j].x); v[j][1] = bfhi(xw[j].x); v[j][2] = bflo(xw[j].y); v[j][3] = bfhi(xw[j].y); v[j][4] = bflo(xw[j].z); v[j][5] = bfhi(xw[j].z); v[j][6] = bflo(xw[j].w); v[j][7] = bfhi(xw[j].w);
#pragma unroll
                for (int q = 0; q < 8; ++q) ssq += v[j][q] * v[j][q]; }
            const float rs = rstd_of(wave_sum(ssq), 1.f / 2048.f);
#pragma unroll
            for (int j = 0; j < 4; ++j) { const f32x4 n0 = *(const f32x4*)(fnw + (lane + 64 * j) * 8), n1 = *(const f32x4*)(fnw + (lane + 64 * j) * 8 + 4);
                f32x4 o0 = {v[j][0] * rs * n0[0], v[j][1] * rs * n0[1], v[j][2] * rs * n0[2], v[j][3] * rs * n0[3]}, o1 = {v[j][4] * rs * n1[0], v[j][5] * rs * n1[1], v[j][6] * rs * n1[2], v[j][7] * rs * n1[3]};
                *(f32x4*)(outp + (size_t)row * DM + (lane + 64 * j) * 8) = o0; *(f32x4*)(outp + (size_t)row * DM + (lane + 64 * j) * 8 + 4) = o1; } }
    }
}

extern "C" void kernel_launch(void* const* d_in, const int* in_sizes, int n_in, void* d_out, int out_size, void* d_ws, size_t ws_size, hipStream_t stream) {
    static int grid = 0;
    if (grid == 0) {
        if (n_in != 20 || ws_size < WS_END) { fprintf(stderr, "kernel_launch: unexpected inputs (n_in %d, ws %zu, need %zu)\n", n_in, ws_size, (size_t)WS_END); grid = -1; return; }
        int dev = 0, cus = 0, per_cu = 0;
        (void)hipGetDevice(&dev); (void)hipDeviceGetAttribute(&cus, hipDeviceAttributeMultiprocessorCount, dev);
        if (hipFuncSetAttribute((const void*)fwd_megakernel, hipFuncAttributeMaxDynamicSharedMemorySize, LDS_BYTES) != hipSuccess) { fprintf(stderr, "kernel_launch: hipFuncSetAttribute failed\n"); grid = -1; return; }
        if (hipOccupancyMaxActiveBlocksPerMultiprocessor(&per_cu, (const void*)fwd_megakernel, 512, LDS_BYTES) != hipSuccess || per_cu < 1) { fprintf(stderr, "kernel_launch: occupancy query gave %d\n", per_cu); per_cu = 1; }
        (void)hipGetLastError();
        grid = cus * 1;
        if (grid <= 0) grid = 256;
    }
    if (grid < 0) return;
    Args a{};
    a.x = (const float*)d_in[0]; a.p = (const float*)d_in[1]; a.positions = (const int*)d_in[2]; a.attn_norm_w = (const float*)d_in[3]; a.ffn_norm_w = (const float*)d_in[4];
    a.ple_norm_w = (const float*)d_in[5]; a.final_norm_w = (const float*)d_in[6]; a.ab_w_in = (const float*)d_in[7]; a.ab_gate_up = (const float*)d_in[8]; a.ab_gate_b = (const float*)d_in[9];
    a.ab_ret_norm_w = (const float*)d_in[10]; a.ab_gla_norm_w = (const float*)d_in[11]; a.ab_w_out = (const float*)d_in[12]; a.c_w_qkv = (const float*)d_in[13]; a.c_w_out = (const float*)d_in[14];
    a.ffn_w_gate = (const float*)d_in[15]; a.ffn_w_up = (const float*)d_in[16]; a.ffn_w_down = (const float*)d_in[17]; a.ple_w_proj = (const float*)d_in[18]; a.ple_w_gate = (const float*)d_in[19];
    a.out = (float*)d_out; a.ws = (unsigned char*)d_ws; a.st_lo = 0; a.st_hi = DBG_HI;
    if (hipMemsetAsync((char*)d_ws + WS_BAR, 0, 16384, stream) != hipSuccess) { fprintf(stderr, "kernel_launch: hipMemsetAsync failed\n"); return; }
    void* args[] = {&a};
    const hipError_t e = hipLaunchCooperativeKernel((const void*)fwd_megakernel, dim3(grid), dim3(512), args, LDS_BYTES, stream);
    if (e != hipSuccess) fprintf(stderr, "kernel_launch: cooperative launch failed: %s (grid %d)\n", hipGetErrorString(e), grid);
}
```
